# Optimizing an MI355X kernel written in HIP

```python
import math
import jax
import jax.numpy as jnp
from jax import lax
import numpy as np

D_MODEL = 2048
BATCH = 2
SEQ = 4096
DEPTH = 2
DEC_BATCH = 8
DEC_SEQ = 8
PAST_LEN = 16384
PAGE_SIZE = 128

N_ATTN_LAYERS = (DEPTH + 1) // 2
N_SSM_LAYERS = DEPTH // 2
ATTN_WIDTH = D_MODEL // 2
CONV_WIDTH = D_MODEL // 2
HEAD_DIM = 128
N_HEADS = ATTN_WIDTH // HEAD_DIM
DILATED_GROUPS = ((128, 1), (512, 4), (2048, 16))
MAX_WINDOW = 2048
BLK = 128
CONV_K = 3
SSM_WIDTH = D_MODEL
SSM_GROUP = 16
SSM_GROUPS = SSM_WIDTH // SSM_GROUP
SSM_STATE = 64
SSM_CHUNK = 128
ROPE_THETA = 10000.0
RMS_EPS = 1e-6

kernel_name = "dilated_attn_shortconv_s5_hybrid_step"


def rms_norm(x, g):
    xf = x.astype(jnp.float32)
    y = xf * lax.rsqrt(jnp.mean(xf * xf, axis=-1, keepdims=True) + RMS_EPS)
    return (y * g.astype(jnp.float32)).astype(x.dtype)


def rotary(x, pos):
    half = HEAD_DIM // 2
    inv = ROPE_THETA ** (-jnp.arange(half, dtype=jnp.float32) / half)
    ang = pos.astype(jnp.float32)[:, None] * inv[None, :]
    cos = jnp.cos(ang)[None, :, None, :]
    sin = jnp.sin(ang)[None, :, None, :]
    xf = x.astype(jnp.float32)
    x1, x2 = xf[..., :half], xf[..., half:]
    return jnp.concatenate([x1 * cos - x2 * sin, x2 * cos + x1 * sin], axis=-1).astype(x.dtype)


def banded_window_attn(q, k, v, n_back):
    n, L, h, dh = q.shape
    nb = -(-L // BLK)
    pad_end = nb * BLK - L
    qb = jnp.pad(q, ((0, 0), (0, pad_end), (0, 0), (0, 0))).reshape(n, nb, BLK, h, dh)

    def kv_blocks(t):
        tp = jnp.pad(t, ((0, 0), (BLK, pad_end), (0, 0), (0, 0))).reshape(n, nb + 1, BLK, h, dh)
        return jnp.concatenate([tp[:, :-1], tp[:, 1:]], axis=2)

    kb, vb = kv_blocks(k), kv_blocks(v)
    s = jnp.einsum('nbqhd,nbkhd->nbhqk', qb, kb, preferred_element_type=jnp.float32) * (dh ** -0.5)
    qi = jnp.arange(BLK)[:, None]
    kj = jnp.arange(2 * BLK)[None, :]
    dist = BLK + qi - kj
    key_pos = jnp.arange(nb)[:, None, None] * BLK + kj[None] - BLK
    valid = ((dist >= 0) & (dist <= n_back))[None] & (key_pos >= 0)
    s = jnp.where(valid[None, :, None], s, -jnp.inf)
    m = jnp.max(s, axis=-1, keepdims=True)
    p = jnp.exp(s - m)
    l = jnp.sum(p, axis=-1, keepdims=True)
    o = jnp.einsum('nbhqk,nbkhd->nbqhd', p, vb.astype(jnp.float32))
    o = o / jnp.swapaxes(l, 2, 3)
    lse = jnp.swapaxes((m + jnp.log(l))[..., 0], 2, 3)
    o = o.reshape(n, nb * BLK, h, dh)[:, :L]
    lse = lse.reshape(n, nb * BLK, h)[:, :L]
    return o, lse


def merge_dilations(outs, lses):
    w = jax.nn.softmax(jnp.stack(lses, axis=0), axis=0)
    return sum(w[g][..., None] * outs[g] for g in range(len(outs)))


def dilated_attn_prompt(q, k, v):
    b, t, h, dh = q.shape
    outs, lses = [], []
    for window, d in DILATED_GROUPS:
        L = t // d

        def split(x):
            return x.reshape(b, L, d, h, dh).transpose(0, 2, 1, 3, 4).reshape(b * d, L, h, dh)

        o, lse = banded_window_attn(split(q), split(k), split(v), window // d)
        outs.append(o.reshape(b, d, L, h, dh).transpose(0, 2, 1, 3, 4).reshape(b, t, h, dh))
        lses.append(lse.reshape(b, d, L, h).transpose(0, 2, 1, 3).reshape(b, t, h))
    return merge_dilations(outs, lses)


def dilated_attn_sample(q, k_all, v_all, n_buf):
    s_len = q.shape[1]
    outs, lses = [], []
    for window, d in DILATED_GROUPS:
        j = jnp.arange(window // d + 1)
        idx = n_buf + jnp.arange(s_len)[:, None] - d * j[None, :]
        valid = idx >= 0
        idxc = jnp.maximum(idx, 0)
        kg = k_all[:, idxc]
        vg = v_all[:, idxc]
        sc = jnp.einsum('bshd,bskhd->bshk', q, kg, preferred_element_type=jnp.float32) * (HEAD_DIM ** -0.5)
        sc = jnp.where(valid[None, :, None, :], sc, -jnp.inf)
        m = jnp.max(sc, axis=-1, keepdims=True)
        p = jnp.exp(sc - m)
        l = jnp.sum(p, axis=-1, keepdims=True)
        o = jnp.einsum('bshk,bskhd->bshd', p, vg.astype(jnp.float32)) / l
        outs.append(o)
        lses.append((m + jnp.log(l))[..., 0])
    return merge_dilations(outs, lses)


def causal_short_conv(u, buf, w):
    up = jnp.concatenate([buf, u], axis=1)
    t = u.shape[1]
    y = sum(up[:, i:i + t] * w[i] for i in range(CONV_K))
    return y, up[:, -(CONV_K - 1):]


def mixer_ab_layer(x, pos, kv_prev, conv_prev, g, w_in, conv_w, w_out):
    b, t, _ = x.shape
    hn = rms_norm(x, g)
    proj = hn @ w_in
    q, k, v, z_a, gate_b, gate_c, h_in, z_b = jnp.split(proj, 8, axis=-1)
    q = rotary(q.reshape(b, t, N_HEADS, HEAD_DIM), pos)
    k = rotary(k.reshape(b, t, N_HEADS, HEAD_DIM), pos)
    v = v.reshape(b, t, N_HEADS, HEAD_DIM)
    if kv_prev is None:
        o_a = dilated_attn_prompt(q, k, v)
        n_keep = min(MAX_WINDOW, t)
        k_state, v_state = k[:, t - n_keep:], v[:, t - n_keep:]
    else:
        k_buf, v_buf = kv_prev
        o_a = dilated_attn_sample(q, jnp.concatenate([k_buf, k], axis=1),
                                  jnp.concatenate([v_buf, v], axis=1), k_buf.shape[1])
        k_state, v_state = k, v
    o_a = o_a.reshape(b, t, ATTN_WIDTH).astype(x.dtype) * jax.nn.silu(z_a)
    conv_out, conv_state = causal_short_conv(gate_c * h_in, conv_prev, conv_w)
    o_b = gate_b * conv_out * jax.nn.silu(z_b)
    y = jnp.concatenate([o_a, o_b], axis=-1) @ w_out
    return x + y, k_state, v_state, conv_state


def s5_discretise(lam_re, lam_im, log_step, b_re, b_im):
    f32 = jnp.float32
    lr, li = lam_re.astype(f32), lam_im.astype(f32)
    step = jnp.exp(log_step.astype(f32))[:, None]
    mag = jnp.exp(lr * step)
    abar_re, abar_im = mag * jnp.cos(li * step), mag * jnp.sin(li * step)
    nr, ni = abar_re - 1.0, abar_im
    den = lr * lr + li * li
    cr = (nr * lr + ni * li) / den
    ci = (ni * lr - nr * li) / den
    br, bi = b_re.astype(f32), b_im.astype(f32)
    bbar_re = cr[..., None] * br - ci[..., None] * bi
    bbar_im = cr[..., None] * bi + ci[..., None] * br
    return abar_re, abar_im, bbar_re, bbar_im


def _ssm_combine(e1, e2):
    a1r, a1i, b1r, b1i = e1
    a2r, a2i, b2r, b2i = e2
    return (a2r * a1r - a2i * a1i, a2r * a1i + a2i * a1r,
            a2r * b1r - a2i * b1i + b2r, a2r * b1i + a2i * b1r + b2i)


def s5_scan(u, h0_re, h0_im, abar_re, abar_im, bbar_re, bbar_im, c_re, c_im, d_skip):
    b, t, _ = u.shape
    f32 = jnp.float32
    chunk = math.gcd(t, SSM_CHUNK)
    n_chunks = t // chunk
    ug = u.astype(f32).reshape(b, n_chunks, chunk, SSM_GROUPS, SSM_GROUP).transpose(1, 0, 2, 3, 4)
    cr, ci = c_re.astype(f32), c_im.astype(f32)

    def step(carry, u_c):
        hr, hi = carry
        bur = jnp.einsum('bcgk,gpk->bcgp', u_c, bbar_re)
        bui = jnp.einsum('bcgk,gpk->bcgp', u_c, bbar_im)
        bur = bur.at[:, 0].add(abar_re * hr - abar_im * hi)
        bui = bui.at[:, 0].add(abar_re * hi + abar_im * hr)
        ar = jnp.broadcast_to(abar_re, bur.shape)
        ai = jnp.broadcast_to(abar_im, bur.shape)
        _, _, sr, si = lax.associative_scan(_ssm_combine, (ar, ai, bur, bui), axis=1)
        y = jnp.einsum('bcgp,gkp->bcgk', sr, cr) - jnp.einsum('bcgp,gkp->bcgk', si, ci)
        return (sr[:, -1], si[:, -1]), y

    (hr, hi), y = lax.scan(step, (h0_re.astype(f32), h0_im.astype(f32)), ug)
    y = y.transpose(1, 0, 2, 3, 4).reshape(b, t, SSM_WIDTH) + d_skip.astype(f32) * u.astype(f32)
    return y, hr, hi


def mixer_c_layer(x, h0_re, h0_im, g, w_in, lam_re, lam_im, log_step, b_re, b_im,
                  c_re, c_im, d_skip, w_glu, b_glu, w_out):
    hn = rms_norm(x, g)
    u, z = jnp.split(hn @ w_in, 2, axis=-1)
    abar_re, abar_im, bbar_re, bbar_im = s5_discretise(lam_re, lam_im, log_step, b_re, b_im)
    y, hr, hi = s5_scan(u, h0_re, h0_im, abar_re, abar_im, bbar_re, bbar_im, c_re, c_im, d_skip)
    y = jax.nn.gelu(y)
    y = y * jax.nn.sigmoid(y @ w_glu.astype(jnp.float32) + b_glu.astype(jnp.float32))
    y = y.astype(x.dtype) * jax.nn.silu(z)
    return x + y @ w_out, hr, hi


def setup_inputs(seed: int = 0) -> dict:
    key = jax.random.key(seed)
    ks = jax.random.split(key, 25)
    f32 = jnp.float32
    n_buf = min(MAX_WINDOW, PAST_LEN)
    nrm = lambda k, shape, s: jax.random.normal(k, shape, f32) * s
    lam_im_init = jnp.pi * jnp.arange(SSM_STATE, dtype=f32)
    return {
        'x_prompt': nrm(ks[0], (BATCH, SEQ, D_MODEL), 1.0),
        'x_sample': nrm(ks[1], (DEC_BATCH, DEC_SEQ, D_MODEL), 1.0),
        'cache_win_k': nrm(ks[2], (N_ATTN_LAYERS, DEC_BATCH, n_buf, N_HEADS, HEAD_DIM), 1.0),
        'cache_win_v': nrm(ks[3], (N_ATTN_LAYERS, DEC_BATCH, n_buf, N_HEADS, HEAD_DIM), 1.0),
        'state_conv': nrm(ks[4], (N_ATTN_LAYERS, DEC_BATCH, CONV_K - 1, CONV_WIDTH), 1.0),
        'state_ssm_re': nrm(ks[5], (N_SSM_LAYERS, DEC_BATCH, SSM_GROUPS, SSM_STATE), 0.1),
        'state_ssm_im': nrm(ks[6], (N_SSM_LAYERS, DEC_BATCH, SSM_GROUPS, SSM_STATE), 0.1),
        'attn_norm': 1.0 + nrm(ks[7], (N_ATTN_LAYERS, D_MODEL), 0.02),
        'w_in_ab': nrm(ks[8], (N_ATTN_LAYERS, D_MODEL, 4 * ATTN_WIDTH + 4 * CONV_WIDTH), D_MODEL ** -0.5),
        'conv_w': nrm(ks[9], (N_ATTN_LAYERS, CONV_K, CONV_WIDTH), CONV_K ** -0.5),
        'w_out_ab': nrm(ks[10], (N_ATTN_LAYERS, ATTN_WIDTH + CONV_WIDTH, D_MODEL), (ATTN_WIDTH + CONV_WIDTH) ** -0.5),
        'ssm_norm': 1.0 + nrm(ks[11], (N_SSM_LAYERS, D_MODEL), 0.02),
        'w_in_c': nrm(ks[12], (N_SSM_LAYERS, D_MODEL, 2 * SSM_WIDTH), D_MODEL ** -0.5),
        'lam_re': -0.5 + nrm(ks[13], (N_SSM_LAYERS, SSM_GROUPS, SSM_STATE), 0.01),
        'lam_im': lam_im_init + nrm(ks[14], (N_SSM_LAYERS, SSM_GROUPS, SSM_STATE), 0.01),
        'log_step': jax.random.uniform(ks[15], (N_SSM_LAYERS, SSM_GROUPS), f32,
                                       minval=math.log(1e-3), maxval=math.log(1e-1)),
        'b_re': nrm(ks[16], (N_SSM_LAYERS, SSM_GROUPS, SSM_STATE, SSM_GROUP), (2 * SSM_GROUP) ** -0.5),
        'b_im': nrm(ks[17], (N_SSM_LAYERS, SSM_GROUPS, SSM_STATE, SSM_GROUP), (2 * SSM_GROUP) ** -0.5),
        'c_re': nrm(ks[18], (N_SSM_LAYERS, SSM_GROUPS, SSM_GROUP, SSM_STATE), SSM_STATE ** -0.5),
        'c_im': nrm(ks[19], (N_SSM_LAYERS, SSM_GROUPS, SSM_GROUP, SSM_STATE), SSM_STATE ** -0.5),
        'd_skip': nrm(ks[20], (N_SSM_LAYERS, SSM_WIDTH), 1.0),
        'w_glu': nrm(ks[21], (N_SSM_LAYERS, SSM_WIDTH, SSM_WIDTH), SSM_WIDTH ** -0.5),
        'b_glu': nrm(ks[22], (N_SSM_LAYERS, SSM_WIDTH), 0.01),
        'w_out_c': nrm(ks[23], (N_SSM_LAYERS, SSM_WIDTH, D_MODEL), SSM_WIDTH ** -0.5),
        'final_norm': 1.0 + nrm(ks[24], (D_MODEL,), 0.02),
    }


def reference(x_prompt, x_sample, cache_win_k, cache_win_v, state_conv, state_ssm_re, state_ssm_im,
              attn_norm, w_in_ab, conv_w, w_out_ab, ssm_norm, w_in_c, lam_re, lam_im, log_step,
              b_re, b_im, c_re, c_im, d_skip, w_glu, b_glu, w_out_c, final_norm):
    bp, tp, _ = x_prompt.shape
    ts = x_sample.shape[1]
    pos_p = jnp.arange(tp)
    pos_s = PAST_LEN + jnp.arange(ts)
    hp, hs = x_prompt, x_sample
    kp_l, vp_l, cp_l, ks_l, vs_l, cs_l = [], [], [], [], [], []
    srp_l, sip_l, srs_l, sis_l = [], [], [], []
    for layer in range(DEPTH):
        i = layer // 2
        if layer % 2 == 0:
            conv0 = jnp.zeros((bp, CONV_K - 1, CONV_WIDTH), hp.dtype)
            hp, kp, vp, cp = mixer_ab_layer(hp, pos_p, None, conv0, attn_norm[i], w_in_ab[i],
                                            conv_w[i], w_out_ab[i])
            hs, ksn, vsn, csn = mixer_ab_layer(hs, pos_s, (cache_win_k[i], cache_win_v[i]), state_conv[i],
                                               attn_norm[i], w_in_ab[i], conv_w[i], w_out_ab[i])
            kp_l.append(kp); vp_l.append(vp); cp_l.append(cp)
            ks_l.append(ksn); vs_l.append(vsn); cs_l.append(csn)
        else:
            h0 = jnp.zeros((bp, SSM_GROUPS, SSM_STATE), jnp.float32)
            hp, rp, ip = mixer_c_layer(hp, h0, h0, ssm_norm[i], w_in_c[i], lam_re[i], lam_im[i], log_step[i],
                                       b_re[i], b_im[i], c_re[i], c_im[i], d_skip[i], w_glu[i], b_glu[i], w_out_c[i])
            hs, rs, is_ = mixer_c_layer(hs, state_ssm_re[i], state_ssm_im[i], ssm_norm[i], w_in_c[i], lam_re[i],
                                        lam_im[i], log_step[i], b_re[i], b_im[i], c_re[i], c_im[i], d_skip[i],
                                        w_glu[i], b_glu[i], w_out_c[i])
            srp_l.append(rp); sip_l.append(ip); srs_l.append(rs); sis_l.append(is_)
    y_prompt = rms_norm(hp, final_norm)
    y_sample = rms_norm(hs, final_norm)
    return (y_prompt, y_sample,
            jnp.stack(kp_l), jnp.stack(vp_l), jnp.stack(cp_l), jnp.stack(srp_l), jnp.stack(sip_l),
            jnp.stack(ks_l), jnp.stack(vs_l), jnp.stack(cs_l), jnp.stack(srs_l), jnp.stack(sis_l))
```

```cpp
#include <hip/hip_runtime.h>
#include <hip/hip_cooperative_groups.h>
#include <cstdio>
#include <cstdint>
namespace cg = cooperative_groups;
#ifndef REP_PHASE
#define REP_PHASE -1
#endif
namespace pg8 {
#define PG8_LAS __attribute__((address_space(3)))
typedef unsigned short bf16_t;
typedef short bf16x8 __attribute__((ext_vector_type(8)));
typedef float f32x4 __attribute__((ext_vector_type(4)));
typedef unsigned u32x4 __attribute__((ext_vector_type(4)));
constexpr int BM = 256, BK = 64, HALF = 128, HTB = HALF * BK * 2  , STAGE_BYTES = 8 * HTB, NXCD = 8, WGM = 8;

__host__ __device__ __forceinline__ int lds_byte(int r, int c) { const int st = (r >> 4) * 2 + (c >> 5), rr = r & 15, cc = c & 31, ob = rr * 64 + cc * 2; return st * 1024 + (ob ^ (((ob >> 9) & 1) << 5)); }
__host__ __device__ __forceinline__ void stage_rc(int b, int& R, int& C) { const int st = b / 1024, sb = b % 1024, swz = sb ^ (((sb >> 9) & 1) << 5); R = (st >> 1) * 16 + swz / 64; C = (st & 1) * 32 + (swz % 64) / 2; }
__host__ __device__ __forceinline__ int perm32(int rho) { const int n = rho >> 4, i = rho & 15; return 8 * (i >> 2) + 4 * n + (i & 3); }

struct Unit { int pm, pn; };
struct Gemm { const bf16_t* A; const bf16_t* Bt; int M, N, K; };

struct StaticOrder {
    int nM, nN, nwg, G, c;
    __host__ __device__ void init(int M, int N, int G_, int c_) { nM = M / BM; nN = N / BM; nwg = nM * nN; G = G_; c = c_; }
    __host__ __device__ bool next(int i, Unit& u) const {
        const long L = (long)i * G + c; if (L >= nwg) return false;
        int wgid = (int)L; { const int q = nwg / NXCD, r = nwg % NXCD, xcd = wgid % NXCD, off = wgid / NXCD; wgid = (xcd < r ? xcd * (q + 1) : r * (q + 1) + (xcd - r) * q) + off; }
        const int nig = WGM * nN, gid = wgid / nig, fm = gid * WGM, gsz = (nM - fm) < WGM ? (nM - fm) : WGM;
        u.pm = fm + ((wgid % nig) % gsz); u.pn = (wgid % nig) / gsz; return true;
    }
    __device__ __forceinline__ void a_ready(const Unit&) const {}
    __device__ __forceinline__ void done(const Unit&) const {}
};

__device__ __forceinline__ unsigned cvt_pk_bf16(float lo, float hi) { unsigned r; asm volatile("v_cvt_pk_bf16_f32 %0, %1, %2" : "=v"(r) : "v"(lo), "v"(hi)); return r; }
typedef float f32x2 __attribute__((ext_vector_type(2)));
template <class Epi, class Sched, bool ALIGN_EPI = false, bool SP2 = false>
__device__ __forceinline__ void gemm_phase(PG8_LAS unsigned char* lds, const Gemm g, const Sched& S, const Epi& E) {
    int tid_ = threadIdx.x; asm volatile("" : "+v"(tid_)); const int tid = tid_, wid = __builtin_amdgcn_readfirstlane(tid >> 6), lane = tid & 63, wr = wid >> 2, wc = wid & 3, fr = lane & 15, fq = lane >> 4;
    const int K = g.K, nt = K / BK;
    unsigned voffA[2], voffB[2];
#pragma unroll
    for (int i = 0; i < 2; ++i) { int R, C; stage_rc(tid * 16 + i * 8192, R, C); const int Rb = Epi::PERM ? ((R & ~31) + perm32(R & 31)) : R;
        voffA[i] = (unsigned)(R * K + C) * 2u; voffB[i] = (unsigned)(Rb * K + C) * 2u; }
    const size_t kstep = (size_t)(BK * 2);
    const size_t hstep = (size_t)HALF * K * 2;
    const size_t tstep = 2 * hstep;
    const unsigned ldsw = (unsigned)wid * 1024u;
    const int aoff = lds_byte(wr * 64 + fr, fq * 8), boff = lds_byte(wc * 32 + fr, fq * 8);
#define PG8_SA(b, h) (((b) * 2 + (h)) * HTB)
#define PG8_SB(b, h) ((4 + (b) * 2 + (h)) * HTB)
#define PG8_STAGE(bufoff, gbase, voff) do { _Pragma("unroll") for (int _i = 0; _i < 2; ++_i) \
        __builtin_amdgcn_global_load_lds((const unsigned*)((const char*)(gbase) + (voff)[_i]), (PG8_LAS unsigned*)(lds + (bufoff) + ldsw + _i * 8192), 16, 0, 0); } while (0)
#define PG8_LDA(dst, b, h) do { _Pragma("unroll") for (int m = 0; m < 4; ++m) _Pragma("unroll") for (int k = 0; k < 2; ++k) dst[m][k] = *(const PG8_LAS bf16x8*)(lds + PG8_SA(b, h) + aoff + m * 2048 + k * 1024); } while (0)
#define PG8_LDB(dst, b, h) do { _Pragma("unroll") for (int n = 0; n < 2; ++n) _Pragma("unroll") for (int k = 0; k < 2; ++k) dst[n][k] = *(const PG8_LAS bf16x8*)(lds + PG8_SB(b, h) + boff + n * 2048 + k * 1024); } while (0)
#define PG8_MMA(ai, bj, At, Bt) do { __builtin_amdgcn_s_setprio(1); _Pragma("unroll") for (int m = 0; m < 4; ++m) _Pragma("unroll") for (int n = 0; n < 2; ++n) _Pragma("unroll") for (int k = 0; k < 2; ++k) \
        acc[ai][bj][m][n] = __builtin_amdgcn_mfma_f32_16x16x32_bf16(Bt[n][k], At[m][k], acc[ai][bj][m][n], 0, 0, 0); __builtin_amdgcn_s_setprio(0); } while (0)
#define PG8_WAIT_V(n) asm volatile("s_waitcnt vmcnt(" #n ")" ::: "memory")
#define PG8_WAIT_L(n) asm volatile("s_waitcnt lgkmcnt(" #n ")" ::: "memory")
#define PG8_BAR __builtin_amdgcn_s_barrier()
#define PG8_SCHED __builtin_amdgcn_sched_barrier(0)
    Unit cur, nxt; int ui = 0;
    if (!S.next(0, cur)) return;
    f32x4 acc[2][2][4][2];
#pragma unroll
    for (int a = 0; a < 2; ++a)
#pragma unroll
        for (int b = 0; b < 2; ++b)
#pragma unroll
            for (int m = 0; m < 4; ++m)
#pragma unroll
                for (int n = 0; n < 2; ++n) acc[a][b][m][n] = (f32x4){0.f, 0.f, 0.f, 0.f};
    bf16x8 At[4][2], B0[2][2], B1[2][2];
    const char* cA = (const char*)g.A + (size_t)cur.pm * tstep; const char* cB = (const char*)g.Bt + (size_t)cur.pn * tstep;
    S.a_ready(cur);
    if constexpr (SP2) {
        PG8_STAGE(PG8_SB(0, 0), cB, voffB); PG8_STAGE(PG8_SB(0, 1), cB + hstep, voffB); PG8_STAGE(PG8_SA(0, 0), cA, voffA); PG8_STAGE(PG8_SA(0, 1), cA + hstep, voffA);
        if (wr == 1) PG8_BAR;
        PG8_WAIT_V(2); PG8_BAR;
        PG8_STAGE(PG8_SB(1, 0), cB + kstep, voffB); PG8_STAGE(PG8_SA(1, 0), cA + kstep, voffA); PG8_STAGE(PG8_SB(1, 1), cB + hstep + kstep, voffB);
        PG8_WAIT_V(6); PG8_BAR;
    } else {
        PG8_STAGE(PG8_SB(0, 0), cB, voffB); PG8_STAGE(PG8_SA(0, 0), cA, voffA); PG8_STAGE(PG8_SB(0, 1), cB + hstep, voffB); PG8_STAGE(PG8_SA(0, 1), cA + hstep, voffA);
        if (wr == 1) PG8_BAR;
        PG8_WAIT_V(4); PG8_BAR;
        PG8_STAGE(PG8_SB(1, 0), cB + kstep, voffB); PG8_STAGE(PG8_SA(1, 0), cA + kstep, voffA); PG8_STAGE(PG8_SB(1, 1), cB + hstep + kstep, voffB);
        PG8_WAIT_V(6); PG8_BAR;
    }
    for (;;) {
        const bool has_next = S.next(ui + 1, nxt);
        const char* nA = has_next ? (const char*)g.A + (size_t)nxt.pm * tstep : cA; const char* nB = has_next ? (const char*)g.Bt + (size_t)nxt.pn * tstep : cB;
        for (int t = 0; t < nt; t += 2) {
            const bool last = (t == nt - 2);
            const char* a1 = cA + (size_t)(t + 1) * kstep;
            const char* a2 = last ? nA : cA + (size_t)(t + 2) * kstep; const char* b2 = last ? nB : cB + (size_t)(t + 2) * kstep;
            const char* a3 = a2 + kstep; const char* b3 = b2 + kstep;
            if (last && has_next) S.a_ready(nxt);
            if constexpr (SP2) {
            PG8_LDB(B0, 0, 0); PG8_LDB(B1, 0, 1); PG8_SCHED; PG8_LDA(At, 0, 0); PG8_STAGE(PG8_SA(1, 1), a1 + hstep, voffA);
            PG8_WAIT_V(8); PG8_WAIT_L(0); PG8_BAR; PG8_MMA(0, 0, At, B0); PG8_MMA(0, 1, At, B1); PG8_BAR; PG8_SCHED;
            PG8_LDA(At, 0, 1); PG8_STAGE(PG8_SB(0, 0), b2, voffB); PG8_STAGE(PG8_SB(0, 1), b2 + hstep, voffB); PG8_STAGE(PG8_SA(0, 0), a2, voffA);
            PG8_WAIT_V(8); PG8_WAIT_L(0); PG8_BAR; PG8_MMA(1, 0, At, B0); PG8_MMA(1, 1, At, B1); PG8_BAR; PG8_SCHED;
            PG8_LDB(B0, 1, 0); PG8_LDB(B1, 1, 1); PG8_SCHED; PG8_LDA(At, 1, 0); PG8_STAGE(PG8_SA(0, 1), a2 + hstep, voffA);
            PG8_WAIT_V(8); PG8_WAIT_L(0); PG8_BAR; PG8_MMA(0, 0, At, B0); PG8_MMA(0, 1, At, B1); PG8_BAR; PG8_SCHED;
            PG8_LDA(At, 1, 1); PG8_STAGE(PG8_SB(1, 0), b3, voffB); PG8_STAGE(PG8_SB(1, 1), b3 + hstep, voffB); PG8_STAGE(PG8_SA(1, 0), a3, voffA);
            PG8_WAIT_V(8); PG8_WAIT_L(0); PG8_BAR; PG8_MMA(1, 0, At, B0); PG8_MMA(1, 1, At, B1); PG8_BAR; PG8_SCHED;
            } else {
            PG8_LDB(B0, 0, 0); PG8_SCHED; PG8_LDA(At, 0, 0); PG8_STAGE(PG8_SA(1, 1), a1 + hstep, voffA);
            PG8_WAIT_L(8); PG8_BAR; PG8_WAIT_L(0); PG8_MMA(0, 0, At, B0); PG8_BAR; PG8_SCHED;
            PG8_LDB(B1, 0, 1); PG8_STAGE(PG8_SB(0, 0), b2, voffB);
            PG8_BAR; PG8_WAIT_L(0); PG8_MMA(0, 1, At, B1); PG8_BAR;
            PG8_LDA(At, 0, 1); PG8_STAGE(PG8_SA(0, 0), a2, voffA);
            PG8_BAR; PG8_WAIT_L(0); PG8_MMA(1, 0, At, B0); PG8_BAR; PG8_SCHED;
            PG8_STAGE(PG8_SB(0, 1), b2 + hstep, voffB);
            PG8_WAIT_V(6); PG8_BAR; PG8_MMA(1, 1, At, B1); PG8_BAR;
            PG8_LDB(B0, 1, 0); PG8_SCHED; PG8_LDA(At, 1, 0); PG8_STAGE(PG8_SA(0, 1), a2 + hstep, voffA);
            PG8_WAIT_L(8); PG8_BAR; PG8_WAIT_L(0); PG8_MMA(0, 0, At, B0); PG8_BAR; PG8_SCHED;
            PG8_LDB(B1, 1, 1); PG8_STAGE(PG8_SB(1, 0), b3, voffB);
            PG8_BAR; PG8_WAIT_L(0); PG8_MMA(0, 1, At, B1); PG8_BAR;
            PG8_LDA(At, 1, 1); PG8_STAGE(PG8_SA(1, 0), a3, voffA);
            PG8_BAR; PG8_WAIT_L(0); PG8_MMA(1, 0, At, B0); PG8_BAR; PG8_SCHED;
            PG8_STAGE(PG8_SB(1, 1), b3 + hstep, voffB);
            PG8_WAIT_V(6); PG8_BAR; PG8_MMA(1, 1, At, B1); PG8_BAR;
            }
        }
        if constexpr (ALIGN_EPI) { if (wr == 0) PG8_BAR; }
        if constexpr (!Epi::AFTER_DRAIN) { E(acc, cur, wr, wc, fr, fq); S.done(cur); }
        if (!has_next) break;
#pragma unroll
        for (int a = 0; a < 2; ++a)
#pragma unroll
            for (int b = 0; b < 2; ++b)
#pragma unroll
                for (int m = 0; m < 4; ++m)
#pragma unroll
                    for (int n = 0; n < 2; ++n) acc[a][b][m][n] = (f32x4){0.f, 0.f, 0.f, 0.f};
        cur = nxt; cA = nA; cB = nB; ++ui;
        if constexpr (ALIGN_EPI) { if (wr == 1) PG8_BAR; }
    }
    PG8_WAIT_V(0);
    if constexpr (!ALIGN_EPI) { if (wr == 0) PG8_BAR; }
    PG8_BAR;
    if constexpr (Epi::AFTER_DRAIN) { E.fused(acc, cur, wr, wc, fr, fq, lds, wid, lane); S.done(cur); }
#undef PG8_SA
#undef PG8_SB
#undef PG8_STAGE
#undef PG8_LDA
#undef PG8_LDB
#undef PG8_MMA
#undef PG8_WAIT_V
#undef PG8_WAIT_L
#undef PG8_BAR
#undef PG8_SCHED
}
}
#define LAS __attribute__((address_space(3)))
typedef unsigned short bf16;
typedef unsigned u32x4 __attribute__((ext_vector_type(4)));
typedef unsigned u32x2 __attribute__((ext_vector_type(2)));
typedef float f32x2 __attribute__((ext_vector_type(2)));
typedef float f32x16 __attribute__((ext_vector_type(16)));
typedef __bf16 bf16x2_t __attribute__((ext_vector_type(2)));
typedef short v4i16_t __attribute__((ext_vector_type(4)));
using pg8::f32x4; using pg8::bf16x8;

constexpr int DM = 2048, TP = 4096, MP = 8192, MS = 64, MR = 8256;
constexpr float RMS_EPS = 1e-6f;
constexpr float LOG2E = 1.4426950408889634f;
constexpr float C2 = 0.08838834764831845f * 1.4426950408889634f;
constexpr int NTHREADS = 512, NWAVES = 8;
constexpr int LDS_BYTES = 131072 + 256;

constexpr size_t OUT_KP = 16908288, OUT_VP = OUT_KP + 4194304, OUT_CP = OUT_VP + 4194304, OUT_SRP = OUT_CP + 4096, OUT_SIP = OUT_SRP + 16384,
                 OUT_KS = OUT_SIP + 16384, OUT_VS = OUT_KS + 65536, OUT_CS = OUT_VS + 65536, OUT_SRS = OUT_CS + 16384, OUT_SIS = OUT_SRS + 65536;
constexpr size_t KiB = 1024, MiB = 1u << 20;
constexpr size_t WS_RS0 = 0, WS_RSS1 = 64 * KiB, WS_RSS2 = 128 * KiB, WS_ABAR = 192 * KiB, WS_BBRE = 256 * KiB, WS_BBIM = 768 * KiB,
                 WS_BFRAG = 1280 * KiB, WS_CFRAG = 1792 * KiB, WS_ROPE = 2816 * KiB, WS_L2G = 5 * MiB, WS_BAR = 5 * MiB + 896 * KiB, WS_CNT = 5 * MiB + 960 * KiB, WS_SBUF = 6 * MiB;
constexpr size_t WS_W1 = 10 * MiB, WS_W2 = 42 * MiB, WS_W3 = 50 * MiB, WS_W4 = 66 * MiB, WS_W5 = 74 * MiB;
constexpr size_t WS_A = 82 * MiB, WS_B = 115 * MiB, WS_C = 148 * MiB, WS_D = 181 * MiB, WS_OG = 214 * MiB, WS_END = 263 * MiB;
constexpr size_t HALF_SLOT = (size_t)MR * 1024 * 2;

__device__ __forceinline__ float bf2f(unsigned short b) { return __uint_as_float(((unsigned)b) << 16); }
__device__ __forceinline__ unsigned cvtpk(float lo, float hi) { f32x2 v = {lo, hi}; bf16x2_t b = __builtin_convertvector(v, bf16x2_t); return __builtin_bit_cast(unsigned, b); }
__device__ __forceinline__ void unpack8(const u32x4 w, float (&f)[8]) {
#pragma unroll
    for (int i = 0; i < 4; ++i) { f[2 * i] = __uint_as_float(w[i] << 16); f[2 * i + 1] = __uint_as_float(w[i] & 0xffff0000u); }
}
__device__ __forceinline__ u32x4 pack8(const float (&f)[8]) { u32x4 w; w.x = cvtpk(f[0], f[1]); w.y = cvtpk(f[2], f[3]); w.z = cvtpk(f[4], f[5]); w.w = cvtpk(f[6], f[7]); return w; }
__device__ __forceinline__ float wave_sum(float v) {
#pragma unroll
    for (int o = 1; o < 64; o <<= 1) v += __shfl_xor(v, o);
    return v;
}
__device__ __forceinline__ float wave_max(float v) {
#pragma unroll
    for (int o = 1; o < 64; o <<= 1) v = fmaxf(v, __shfl_xor(v, o));
    return v;
}
__device__ __forceinline__ float sigmoid_f(float x) { return __builtin_amdgcn_rcpf(1.0f + __builtin_amdgcn_exp2f(-x * LOG2E)); }
__device__ __forceinline__ float silu_f(float x) { return x * sigmoid_f(x); }
__device__ __forceinline__ float gelu_tanh_f(float y) { const float t = 0.7978845608028654f * (y + 0.044715f * y * y * y); return y * sigmoid_f(2.0f * t); }
__device__ __forceinline__ int crow(int i, int h) { return (i & 3) + 8 * (i >> 2) + 4 * h; }
#define MFMA32(a, b, c) __builtin_amdgcn_mfma_f32_32x32x16_bf16((a), (b), (c), 0, 0, 0)
__device__ __forceinline__ v4i16_t tr_read(LAS const unsigned char* p) { return __builtin_amdgcn_ds_read_tr16_b64_v4i16((LAS v4i16_t*)p); }
__device__ __forceinline__ void sincos_acc(float ang, float& s_out, float& c_out) {
    double rev = (double)ang * 0.15915494309189535; rev -= __builtin_rint(rev);
    const double x = rev * 6.283185307179586 * 0.125, x2 = x * x;
    double s = x * (1.0 - x2 / 6.0 * (1.0 - x2 / 20.0 * (1.0 - x2 / 42.0 * (1.0 - x2 / 72.0 * (1.0 - x2 / 110.0 * (1.0 - x2 / 156.0))))));
    double c = 1.0 - x2 / 2.0 * (1.0 - x2 / 12.0 * (1.0 - x2 / 30.0 * (1.0 - x2 / 56.0 * (1.0 - x2 / 90.0 * (1.0 - x2 / 132.0 * (1.0 - x2 / 182.0))))));
#pragma unroll
    for (int i = 0; i < 3; ++i) { const double s2 = 2.0 * s * c, c2 = 1.0 - 2.0 * s * s; s = s2; c = c2; }
    s_out = (float)s; c_out = (float)c;
}

struct Params {
    const float *x_prompt, *x_sample, *cache_k, *cache_v, *state_conv, *ssm_re, *ssm_im, *attn_norm, *w_in_ab, *conv_w, *w_out_ab, *ssm_norm, *w_in_c,
        *lam_re, *lam_im, *log_step, *b_re, *b_im, *c_re, *c_im, *d_skip, *w_glu, *b_glu, *w_out_c, *final_norm;
    float* out; unsigned char* ws;
};

__device__ __forceinline__ int w1_dst(int c) {
    if (c < 2048) { const int sec = c >> 10, head = (c & 1023) >> 7, d = c & 127, n = d >> 6, dd = d & 63; const int pn = sec * 4 + (head >> 1), bj = head & 1;
        return pn * 256 + bj * 128 + (dd >> 2) * 8 + n * 4 + (dd & 3); }
    if (c < 4096) return c;
    const int sec = (c >> 10) - 4, ch = c & 1023, qt = ch >> 6;
    return (16 + qt) * 256 + ((ch & 63) << 2) + sec;
}
template <bool MAP> __device__ __forceinline__ void p0_transpose_item(const float* W, int K, int N, bf16* WT, const float* gs, LAS float* scr, int item, int lane) {
    const int nblk = N / 32, kb = item / nblk, nb = item % nblk, k0 = 64 * kb, n0 = 32 * nb;
    float tv[32];
#pragma unroll
    for (int i = 0; i < 32; ++i) { const int kk = 2 * i + (lane >> 5); tv[i] = W[(size_t)(k0 + kk) * N + n0 + (lane & 31)]; }
    if (gs) {
#pragma unroll
        for (int i = 0; i < 32; ++i) tv[i] *= gs[k0 + 2 * i + (lane >> 5)];
    }
#pragma unroll
    for (int i = 0; i < 32; ++i) scr[(2 * i + (lane >> 5)) * 33 + (lane & 31)] = tv[i];
    asm volatile("s_waitcnt lgkmcnt(0)" ::: "memory");
    const int c = lane & 7;
#pragma unroll
    for (int j = 0; j < 4; ++j) { const int n = (lane >> 3) + 8 * j; const LAS float* s = scr + (8 * c) * 33 + n;
        u32x4 o; o.x = cvtpk(s[0 * 33], s[1 * 33]); o.y = cvtpk(s[2 * 33], s[3 * 33]); o.z = cvtpk(s[4 * 33], s[5 * 33]); o.w = cvtpk(s[6 * 33], s[7 * 33]);
        const int row = MAP ? w1_dst(n0 + n) : (n0 + n);
        *(u32x4*)(WT + (size_t)row * K + k0 + 8 * c) = o; }
    asm volatile("s_waitcnt lgkmcnt(0)" ::: "memory");
}

__device__ __forceinline__ void p0_prologue(const Params& P, LAS unsigned char* lds, int gw, int NGW, int lane, int wave) {
    unsigned char* ws = P.ws;
    LAS float* scr = (LAS float*)(lds + wave * 16384);
    constexpr int I1 = 32 * 256, I2 = 32 * 64, I3 = 32 * 128, I4 = 32 * 64, I5 = 32 * 64, NIT = I1 + I2 + I3 + I4 + I5;
    for (int it = gw; it < NIT; it += NGW) {
        int r = it;
        if (r < I1) { p0_transpose_item<true>(P.w_in_ab, 2048, 8192, (bf16*)(ws + WS_W1), P.attn_norm, scr, r, lane); continue; } r -= I1;
        if (r < I2) { p0_transpose_item<false>(P.w_out_ab, 2048, 2048, (bf16*)(ws + WS_W2), nullptr, scr, r, lane); continue; } r -= I2;
        if (r < I3) { p0_transpose_item<false>(P.w_in_c, 2048, 4096, (bf16*)(ws + WS_W3), P.ssm_norm, scr, r, lane); continue; } r -= I3;
        if (r < I4) { p0_transpose_item<false>(P.w_glu, 2048, 2048, (bf16*)(ws + WS_W4), nullptr, scr, r, lane); continue; } r -= I4;
        p0_transpose_item<false>(P.w_out_c, 2048, 2048, (bf16*)(ws + WS_W5), nullptr, scr, r, lane);
    }
    float* rs0 = (float*)(ws + WS_RS0); float* rss1 = (float*)(ws + WS_RSS1); float* rss2 = (float*)(ws + WS_RSS2);
    bf16* X0 = (bf16*)(ws + WS_A);
    for (int row = gw; row < MR; row += NGW) {
        const float* src = row < MP ? P.x_prompt + (size_t)row * DM : P.x_sample + (size_t)(row - MP) * DM;
        const f32x4* s4 = (const f32x4*)src + lane; f32x4 v[8]; float ss = 0.f;
#pragma unroll
        for (int j = 0; j < 8; ++j) { v[j] = s4[64 * j]; ss += (v[j].x * v[j].x + v[j].y * v[j].y) + (v[j].z * v[j].z + v[j].w * v[j].w); }
        ss = wave_sum(ss);
        u32x2* o8 = (u32x2*)(X0 + (size_t)row * DM) + lane;
#pragma unroll
        for (int j = 0; j < 8; ++j) { u32x2 w; w.x = cvtpk(v[j].x, v[j].y); w.y = cvtpk(v[j].z, v[j].w); o8[64 * j] = w; }
        if (lane == 0) { rs0[row] = 1.0f / sqrtf(ss * (1.0f / DM) + RMS_EPS); rss1[row] = 0.f; rss2[row] = 0.f; }
    }
    const int gt = gw * 64 + lane, NGT = NGW * 64;
    float* rope = (float*)(ws + WS_ROPE);
    for (int i = gt; i < 4104 * 64; i += NGT) {
        const int pi = i >> 6, d = i & 63; const int pos = pi < 4096 ? pi : (16384 + pi - 4096);
        double inv = 1.0; for (int k = 0; k < d; ++k) inv *= 0.8659643233600653;
        const float ang = (float)pos * (float)inv; float s, c; sincos_acc(ang, s, c);
        rope[2 * i] = c; rope[2 * i + 1] = s;
    }
    float* ABAR = (float*)(ws + WS_ABAR); float* BBRE = (float*)(ws + WS_BBRE); float* BBIM = (float*)(ws + WS_BBIM);
    bf16* BFRAG = (bf16*)(ws + WS_BFRAG); bf16* CFRAG = (bf16*)(ws + WS_CFRAG);
    for (int it = gt; it < 128 * 64 * 16; it += NGT) {
        const int i = it >> 4, k = it & 15, g = i >> 6, p = i & 63;
        const float lr = P.lam_re[i], li = P.lam_im[i], step = __expf(P.log_step[g]);
        const float mag = __expf(lr * step); float sn, cs; sincos_acc(li * step, sn, cs);
        const float ar = mag * cs, ai = mag * sn;
        if (k == 0) { ABAR[2 * i] = ar; ABAR[2 * i + 1] = ai; }
        const float nr = ar - 1.0f, ni = ai, den = lr * lr + li * li; const float cr = (nr * lr + ni * li) / den, ci = (ni * lr - nr * li) / den;
        const float br = P.b_re[it], bi = P.b_im[it]; const float bbr = cr * br - ci * bi, bbi = cr * bi + ci * br;
        BBRE[it] = bbr; BBIM[it] = bbi;
        const int r = p & 31, blk = p >> 5, ln = r + 32 * (k >> 3), j = k & 7;
        BFRAG[((size_t)(g * 4 + blk) * 64 + ln) * 8 + j] = (bf16)(cvtpk(bbr, 0.f) & 0xffffu);
        BFRAG[((size_t)(g * 4 + 2 + blk) * 64 + ln) * 8 + j] = (bf16)(cvtpk(bbi, 0.f) & 0xffffu);
    }
    for (int it = gt; it < 128 * 8 * 64; it += NGT) {
        const int ln = it & 63, sidx = (it >> 6) & 7, g = it >> 9, ch = ln & 31, h = ln >> 5, comp0 = 16 * sidx + 8 * h;
        float v[8];
#pragma unroll
        for (int e = 0; e < 8; ++e) v[e] = 0.f;
        if (ch < 16) {
            if (comp0 < 64) { const f32x4 a = *(const f32x4*)(P.c_re + ((size_t)g * 16 + ch) * 64 + comp0), b = *(const f32x4*)(P.c_re + ((size_t)g * 16 + ch) * 64 + comp0 + 4);
                v[0] = a[0]; v[1] = a[1]; v[2] = a[2]; v[3] = a[3]; v[4] = b[0]; v[5] = b[1]; v[6] = b[2]; v[7] = b[3]; }
            else { const f32x4 a = *(const f32x4*)(P.c_im + ((size_t)g * 16 + ch) * 64 + comp0 - 64), b = *(const f32x4*)(P.c_im + ((size_t)g * 16 + ch) * 64 + comp0 - 60);
                v[0] = -a[0]; v[1] = -a[1]; v[2] = -a[2]; v[3] = -a[3]; v[4] = -b[0]; v[5] = -b[1]; v[6] = -b[2]; v[7] = -b[3]; }
        }
        *(u32x4*)(CFRAG + (size_t)it * 8) = pack8(v);
    }
}

struct NoCol {};
struct E1 {
    bf16 *Q, *K, *V, *SZA, *CH, *GB; const float* rs0; const float* rope; float* out;
    struct Pre { float rs; f32x4 r0, r1; }; typedef NoCol Col;
    __device__ __forceinline__ Col colpre(int, int) const { return Col{}; }
    __device__ __forceinline__ Pre load(int row, int pn, int pos8) const {
        Pre p; p.rs = rs0[row]; p.r0 = (f32x4){0.f, 0.f, 0.f, 0.f}; p.r1 = p.r0;
        if (pn < 8) { const int posidx = row < MP ? (row & 4095) : (4096 + ((row - MP) & 7)); const int dq = (pos8 & 127) >> 1;
            const f32x4* rp = (const f32x4*)(rope + ((size_t)posidx * 64 + dq) * 2); p.r0 = rp[0]; p.r1 = rp[1]; }
        return p;
    }
    __device__ __forceinline__ float apply(int row, int pn, int pos8, const float (&a)[8], const Pre& pre, const Col&) const {
        const float rs = pre.rs; float v[8];
#pragma unroll
        for (int e = 0; e < 8; ++e) v[e] = a[e] * rs;
        const bool isp = row < MP; const int srow = row - MP;
        if (pn < 8) {
            const int head = 2 * (pn & 3) + (pos8 >> 7), dq = (pos8 & 127) >> 1;
            const f32x4 r0 = pre.r0, r1 = pre.r1;
            const float cs[4] = {r0[0], r0[2], r1[0], r1[2]}, sn[4] = {r0[1], r0[3], r1[1], r1[3]};
            float o1[4], o2[4];
#pragma unroll
            for (int j = 0; j < 4; ++j) { o1[j] = v[j] * cs[j] - v[4 + j] * sn[j]; o2[j] = v[4 + j] * cs[j] + v[j] * sn[j]; }
            const int col = head * 128 + dq;
            if (pn < 4) {
                u32x2 w1, w2; w1.x = cvtpk(o1[0] * C2, o1[1] * C2); w1.y = cvtpk(o1[2] * C2, o1[3] * C2); w2.x = cvtpk(o2[0] * C2, o2[1] * C2); w2.y = cvtpk(o2[2] * C2, o2[3] * C2);
                *(u32x2*)(Q + (size_t)row * 1024 + col) = w1; *(u32x2*)(Q + (size_t)row * 1024 + col + 64) = w2;
            } else {
                u32x2 w1, w2; w1.x = cvtpk(o1[0], o1[1]); w1.y = cvtpk(o1[2], o1[3]); w2.x = cvtpk(o2[0], o2[1]); w2.y = cvtpk(o2[2], o2[3]);
                *(u32x2*)(K + (size_t)row * 1024 + col) = w1; *(u32x2*)(K + (size_t)row * 1024 + col + 64) = w2;
                float* dst = nullptr;
                if (isp) { const int t = row & 4095; if (t >= 2048) dst = out + OUT_KP + ((size_t)(row >> 12) * 2048 + (t - 2048)) * 1024; }
                else dst = out + OUT_KS + (size_t)srow * 1024;
                if (dst) { *(f32x4*)(dst + col) = (f32x4){o1[0], o1[1], o1[2], o1[3]}; *(f32x4*)(dst + col + 64) = (f32x4){o2[0], o2[1], o2[2], o2[3]}; }
            }
        } else if (pn < 12) {
            const int col = (pn - 8) * 256 + pos8;
            *(u32x4*)(V + (size_t)row * 1024 + col) = pack8(v);
            float* dst = nullptr;
            if (isp) { const int t = row & 4095; if (t >= 2048) dst = out + OUT_VP + ((size_t)(row >> 12) * 2048 + (t - 2048)) * 1024; }
            else dst = out + OUT_VS + (size_t)srow * 1024;
            if (dst) { *(f32x4*)(dst + col) = (f32x4){v[0], v[1], v[2], v[3]}; *(f32x4*)(dst + col + 4) = (f32x4){v[4], v[5], v[6], v[7]}; }
        } else if (pn < 16) {
            const int col = (pn - 12) * 256 + pos8; float sv[8];
#pragma unroll
            for (int e = 0; e < 8; ++e) sv[e] = silu_f(v[e]);
            *(u32x4*)(SZA + (size_t)row * 1024 + col) = pack8(sv);
        } else {
            const int chn = (pn - 16) * 64 + (pos8 >> 2);
            const float ch0 = v[1] * v[2], ch1 = v[5] * v[6]; const float g0 = v[0] * silu_f(v[3]), g1 = v[4] * silu_f(v[7]);
            *(unsigned*)(CH + (size_t)row * 1024 + chn) = cvtpk(ch0, ch1);
            *(unsigned*)(GB + (size_t)row * 1024 + chn) = cvtpk(g0, g1);
            if (isp) { const int t = row & 4095; if (t >= 4094) { float* d = out + OUT_CP + ((size_t)(row >> 12) * 2 + (t - 4094)) * 1024 + chn; d[0] = ch0; d[1] = ch1; } }
            else { const int sx = srow & 7; if (sx >= 6) { float* d = out + OUT_CS + ((size_t)(srow >> 3) * 2 + (sx - 6)) * 1024 + chn; d[0] = ch0; d[1] = ch1; } }
        }
        return 0.f;
    }
};
struct E2 {
    const float *xp, *xs; bf16* H1b;
    struct Pre { f32x4 x0, x1; }; typedef NoCol Col;
    __device__ __forceinline__ Col colpre(int, int) const { return Col{}; }
    __device__ __forceinline__ Pre load(int row, int pn, int pos8) const {
        const float* xr = (row < MP ? xp + (size_t)row * DM : xs + (size_t)(row - MP) * DM) + pn * 256 + pos8;
        return Pre{*(const f32x4*)xr, *(const f32x4*)(xr + 4)};
    }
    __device__ __forceinline__ float apply(int row, int pn, int pos8, const float (&a)[8], const Pre& pre, const Col&) const {
        const int col = pn * 256 + pos8; const f32x4 x0 = pre.x0, x1 = pre.x1;
        float h[8] = {x0[0] + a[0], x0[1] + a[1], x0[2] + a[2], x0[3] + a[3], x1[0] + a[4], x1[1] + a[5], x1[2] + a[6], x1[3] + a[7]};
        *(u32x4*)(H1b + (size_t)row * DM + col) = pack8(h);
        float ss = 0.f;
#pragma unroll
        for (int e = 0; e < 8; ++e) ss += h[e] * h[e];
        return ss;
    }
};
struct E3 {
    const float* rss1; bf16 *U, *ZS;
    struct Pre { float rss; }; typedef NoCol Col;
    __device__ __forceinline__ Col colpre(int, int) const { return Col{}; }
    __device__ __forceinline__ Pre load(int row, int, int) const { return Pre{rss1[row]}; }
    __device__ __forceinline__ float apply(int row, int pn, int pos8, const float (&a)[8], const Pre& pre, const Col&) const {
        const float rs = 1.0f / sqrtf(pre.rss * (1.0f / DM) + RMS_EPS); float v[8];
        if (pn < 8) {
#pragma unroll
            for (int e = 0; e < 8; ++e) v[e] = a[e] * rs;
            *(u32x4*)(U + (size_t)row * DM + pn * 256 + pos8) = pack8(v);
        } else {
#pragma unroll
            for (int e = 0; e < 8; ++e) v[e] = silu_f(a[e] * rs);
            *(u32x4*)(ZS + (size_t)row * DM + (pn - 8) * 256 + pos8) = pack8(v);
        }
        return 0.f;
    }
};
struct E4 {
    const bf16 *YG, *ZS; const float* bglu; bf16* ACT2;
    struct Pre { u32x4 y, z; }; struct Col { f32x4 b0, b1; };
    __device__ __forceinline__ Col colpre(int pn, int pos8) const { const int col = pn * 256 + pos8; return Col{*(const f32x4*)(bglu + col), *(const f32x4*)(bglu + col + 4)}; }
    __device__ __forceinline__ Pre load(int row, int pn, int pos8) const { const size_t off = (size_t)row * DM + pn * 256 + pos8; return Pre{*(const u32x4*)(YG + off), *(const u32x4*)(ZS + off)}; }
    __device__ __forceinline__ float apply(int row, int pn, int pos8, const float (&a)[8], const Pre& pre, const Col& cp) const {
        const size_t off = (size_t)row * DM + pn * 256 + pos8;
        float y[8], z[8], o[8]; unpack8(pre.y, y); unpack8(pre.z, z);
        const float bb[8] = {cp.b0[0], cp.b0[1], cp.b0[2], cp.b0[3], cp.b1[0], cp.b1[1], cp.b1[2], cp.b1[3]};
#pragma unroll
        for (int e = 0; e < 8; ++e) o[e] = y[e] * sigmoid_f(a[e] + bb[e]) * z[e];
        *(u32x4*)(ACT2 + off) = pack8(o);
        return 0.f;
    }
};
struct E5 {
    const bf16* H1b; float* out;
    struct Pre { u32x4 h; }; typedef NoCol Col;
    __device__ __forceinline__ Col colpre(int, int) const { return Col{}; }
    __device__ __forceinline__ Pre load(int row, int pn, int pos8) const { return Pre{*(const u32x4*)(H1b + (size_t)row * DM + pn * 256 + pos8)}; }
    __device__ __forceinline__ float apply(int row, int pn, int pos8, const float (&a)[8], const Pre& pre, const Col&) const {
        float* o = out + (size_t)row * DM + pn * 256 + pos8; float x[8]; unpack8(pre.h, x);
        const float h[8] = {x[0] + a[0], x[1] + a[1], x[2] + a[2], x[3] + a[3], x[4] + a[4], x[5] + a[5], x[6] + a[6], x[7] + a[7]};
        *(f32x4*)o = (f32x4){h[0], h[1], h[2], h[3]}; *(f32x4*)(o + 4) = (f32x4){h[4], h[5], h[6], h[7]};
        float ss = 0.f;
#pragma unroll
        for (int e = 0; e < 8; ++e) ss += h[e] * h[e];
        return ss;
    }
};
struct E5F {
    static constexpr bool PERM = true, AFTER_DRAIN = true;
    const bf16* H1b; float* out; float* rss2; unsigned* cnt; const float* fnorm;
    __device__ __forceinline__ void fused(f32x4 (&acc)[2][2][4][2], const pg8::Unit& u, int wr, int wc, int fr, int fq, LAS unsigned char*, int, int) const {
#pragma unroll
        for (int am = 0; am < 4; ++am) {
            const int ai = am >> 1, m0 = (am & 1) * 2; u32x4 pre[2][2];
#pragma unroll
            for (int mm = 0; mm < 2; ++mm)
#pragma unroll
                for (int bj = 0; bj < 2; ++bj) pre[mm][bj] = *(const u32x4*)(H1b + (size_t)(u.pm * 256 + ai * 128 + wr * 64 + (m0 + mm) * 16 + fr) * DM + u.pn * 256 + bj * 128 + wc * 32 + 8 * fq);
#pragma unroll
            for (int mm = 0; mm < 2; ++mm) {
                const int m = m0 + mm, row = u.pm * 256 + ai * 128 + wr * 64 + m * 16 + fr; float ss = 0.f;
#pragma unroll
                for (int bj = 0; bj < 2; ++bj) { float x[8]; unpack8(pre[mm][bj], x);
                    acc[ai][bj][m][0] += (f32x4){x[0], x[1], x[2], x[3]}; acc[ai][bj][m][1] += (f32x4){x[4], x[5], x[6], x[7]};
                    const f32x4 c0 = acc[ai][bj][m][0], c1 = acc[ai][bj][m][1];
                    ss += (c0[0] * c0[0] + c0[1] * c0[1]) + (c0[2] * c0[2] + c0[3] * c0[3]) + (c1[0] * c1[0] + c1[1] * c1[1]) + (c1[2] * c1[2] + c1[3] * c1[3]); }
                ss += __shfl_xor(ss, 16); ss += __shfl_xor(ss, 32); if (fq == 0) unsafeAtomicAdd(rss2 + row, ss);
            }
        }
        asm volatile("s_waitcnt vmcnt(0)" ::: "memory");
        __syncthreads();
        if (threadIdx.x == 0) {
            unsigned* c = cnt + 64 * u.pm;
            __hip_atomic_fetch_add(c, 1u, __ATOMIC_RELAXED, __HIP_MEMORY_SCOPE_AGENT);
            unsigned sp = 0;
            while (__hip_atomic_load(c, __ATOMIC_RELAXED, __HIP_MEMORY_SCOPE_AGENT) < 8u) { __builtin_amdgcn_s_sleep(1); if (++sp > (1u << 22)) break; }
            __builtin_amdgcn_fence(__ATOMIC_ACQUIRE, "agent");
            asm volatile("s_waitcnt vmcnt(0)" ::: "memory");
        }
        __syncthreads();
        f32x4 gn[2][2];
#pragma unroll
        for (int bj = 0; bj < 2; ++bj) { const float* gp = fnorm + u.pn * 256 + bj * 128 + wc * 32 + 8 * fq; gn[bj][0] = *(const f32x4*)gp; gn[bj][1] = *(const f32x4*)(gp + 4); }
#pragma unroll
        for (int ai = 0; ai < 2; ++ai)
#pragma unroll
            for (int m = 0; m < 4; ++m) {
                const int row = u.pm * 256 + ai * 128 + wr * 64 + m * 16 + fr;
                const float rs = 1.0f / sqrtf(__hip_atomic_load(rss2 + row, __ATOMIC_RELAXED, __HIP_MEMORY_SCOPE_AGENT) * (1.0f / DM) + RMS_EPS);
#pragma unroll
                for (int bj = 0; bj < 2; ++bj) { float* o = out + (size_t)row * DM + u.pn * 256 + bj * 128 + wc * 32 + 8 * fq;
                    *(f32x4*)o = acc[ai][bj][m][0] * rs * gn[bj][0]; *(f32x4*)(o + 4) = acc[ai][bj][m][1] * rs * gn[bj][1]; }
            }
    }
};
template <class EF, bool RSS> struct EpiWrap {
    static constexpr bool PERM = true, AFTER_DRAIN = false;
    EF ef; float* rss;
    __device__ __forceinline__ void operator()(const f32x4 (&acc)[2][2][4][2], const pg8::Unit& u, int wr, int wc, int fr, int fq) const {
        typename EF::Col cp[2];
#pragma unroll
        for (int bj = 0; bj < 2; ++bj) cp[bj] = ef.colpre(u.pn, bj * 128 + wc * 32 + 8 * fq);
#pragma unroll
        for (int am = 0; am < 4; ++am) {
            const int ai = am >> 1, m0 = (am & 1) * 2;
            typename EF::Pre pre[2][2];
#pragma unroll
            for (int mm = 0; mm < 2; ++mm)
#pragma unroll
                for (int bj = 0; bj < 2; ++bj) pre[mm][bj] = ef.load(u.pm * 256 + ai * 128 + wr * 64 + (m0 + mm) * 16 + fr, u.pn, bj * 128 + wc * 32 + 8 * fq);
            asm volatile("" ::: "memory");
#pragma unroll
            for (int mm = 0; mm < 2; ++mm) {
                const int m = m0 + mm;
                const int row = u.pm * 256 + ai * 128 + wr * 64 + m * 16 + fr; float ss = 0.f;
#pragma unroll
                for (int bj = 0; bj < 2; ++bj) {
                    const f32x4 c0 = acc[ai][bj][m][0], c1 = acc[ai][bj][m][1];
                    const float a[8] = {c0[0], c0[1], c0[2], c0[3], c1[0], c1[1], c1[2], c1[3]};
                    ss += ef.apply(row, u.pn, bj * 128 + wc * 32 + 8 * fq, a, pre[mm][bj], cp[bj]);
                }
                if (RSS) { ss += __shfl_xor(ss, 16); ss += __shfl_xor(ss, 32); if (fq == 0) unsafeAtomicAdd(rss + row, ss); }
            }
            asm volatile("" ::: "memory");
        }
    }
};
template <class EF, bool RSS> __device__ __forceinline__ void skinny_gemm(LAS unsigned char* lds, const bf16* A, const bf16* Bt, int N, const EF& ef, float* rss, int vcu, int G) {
    constexpr int K = 2048;
    int tid_ = threadIdx.x; asm volatile("" : "+v"(tid_)); const int tid = tid_, lane = tid & 63, wid = __builtin_amdgcn_readfirstlane(tid >> 6), r = lane & 31, h = lane >> 5;
    LAS float* red = (LAS float*)lds;
    const int nsl = N / 32;
    for (int sl = vcu; sl < nsl; sl += G) {
        const int n0 = sl * 32, kw = wid & 3, rt = wid >> 2;
        const bf16* ap = A + (size_t)(rt * 32 + r) * K + kw * 512 + 8 * h;
        const bf16* bp = Bt + (size_t)(n0 + r) * K + kw * 512 + 8 * h;
        f32x16 acc;
#pragma unroll
        for (int i = 0; i < 16; ++i) acc[i] = 0.f;
#pragma unroll 1
        for (int s0 = 0; s0 < 32; s0 += 16) {
            bf16x8 af[16], bfv[16];
#pragma unroll
            for (int s = 0; s < 16; ++s) { af[s] = *(const bf16x8*)(ap + 16 * (s0 + s)); bfv[s] = *(const bf16x8*)(bp + 16 * (s0 + s)); }
#pragma unroll
            for (int s = 0; s < 16; ++s) acc = MFMA32(af[s], bfv[s], acc);
        }
#pragma unroll
        for (int i = 0; i < 16; ++i) red[(wid * 32 + crow(i, h)) * 33 + r] = acc[i];
        __syncthreads();
        if (tid < 256) {
            const int row = tid >> 2, cgp = tid & 3, rt2 = row >> 5, rr = row & 31; float v[8];
#pragma unroll
            for (int e = 0; e < 8; ++e) { float s = 0.f;
#pragma unroll
                for (int k = 0; k < 4; ++k) s += red[((rt2 * 4 + k) * 32 + rr) * 33 + 8 * cgp + e];
                v[e] = s; }
            const typename EF::Col cpre = ef.colpre(n0 >> 8, (n0 & 255) + 8 * cgp);
            const typename EF::Pre pre = ef.load(MP + row, n0 >> 8, (n0 & 255) + 8 * cgp);
            float ss = ef.apply(MP + row, n0 >> 8, (n0 & 255) + 8 * cgp, v, pre, cpre);
            if (RSS) { ss += __shfl_xor(ss, 1); ss += __shfl_xor(ss, 2); if (cgp == 0) unsafeAtomicAdd(rss + MP + row, ss); }
        }
        __syncthreads();
    }
}
template <class EF, bool RSS> __device__ __forceinline__ void gemm_all(LAS unsigned char* lds, const bf16* A, const bf16* Bt, int N, const EF& ef, float* rss, int vcu, int G) {
    skinny_gemm<EF, RSS>(lds, A + (size_t)MP * 2048, Bt, N, ef, rss, vcu, G);
    pg8::Gemm g{A, Bt, MP, N, 2048}; pg8::StaticOrder S; S.init(MP, N, G, (int)blockIdx.x);
    EpiWrap<EF, RSS> E{ef, rss};
    pg8::gemm_phase<EpiWrap<EF, RSS>, pg8::StaticOrder, true, true>(lds, g, S, E);
}

__device__ __forceinline__ void gemm5_fused(LAS unsigned char* lds, const bf16* A, const bf16* Bt, const bf16* H1b, float* out, float* rss2, unsigned* cnt, const float* fnorm, int vcu, int G) {
    E5 es{H1b, out};
    skinny_gemm<E5, true>(lds, A + (size_t)MP * 2048, Bt, 2048, es, rss2, vcu, G);
    asm volatile("s_waitcnt vmcnt(0)" ::: "memory");
    __syncthreads();
    if (vcu < 64 && threadIdx.x == 0) __hip_atomic_fetch_add(cnt + 64 * 40, 1u, __ATOMIC_RELAXED, __HIP_MEMORY_SCOPE_AGENT);
    pg8::Gemm g{A, Bt, MP, 2048, 2048}; pg8::StaticOrder S; S.init(MP, 2048, G, (int)blockIdx.x);
    E5F E{H1b, out, rss2, cnt, fnorm};
    pg8::gemm_phase<E5F, pg8::StaticOrder, false, true>(lds, g, S, E);
    if (vcu < 64) {
        if (threadIdx.x == 0) { unsigned sp = 0; while (__hip_atomic_load(cnt + 64 * 40, __ATOMIC_RELAXED, __HIP_MEMORY_SCOPE_AGENT) < 64u) { __builtin_amdgcn_s_sleep(1); if (++sp > (1u << 22)) break; }
            __builtin_amdgcn_fence(__ATOMIC_ACQUIRE, "agent"); asm volatile("s_waitcnt vmcnt(0)" ::: "memory"); }
        __syncthreads();
        const int tid = threadIdx.x;
        if (tid < 256) { const int row = MP + (tid >> 2), col = vcu * 32 + 8 * (tid & 3);
            const float rs = 1.0f / sqrtf(__hip_atomic_load(rss2 + row, __ATOMIC_RELAXED, __HIP_MEMORY_SCOPE_AGENT) * (1.0f / DM) + RMS_EPS);
            float* o = out + (size_t)row * DM + col; const f32x4 g0 = *(const f32x4*)(fnorm + col), g1 = *(const f32x4*)(fnorm + col + 4);
            const f32x4 v0 = *(const f32x4*)o, v1 = *(const f32x4*)(o + 4);
            *(f32x4*)o = v0 * rs * g0; *(f32x4*)(o + 4) = v1 * rs * g1; }
    }
}

__device__ __forceinline__ void attn_prompt_phase(LAS unsigned char* lds, const bf16* Q, const bf16* K, const bf16* V, bf16* OG, float* L2G, int vcu, int G, int gsel = -1) {
    int tid_ = threadIdx.x; asm volatile("" : "+v"(tid_)); const int tid = tid_, lane = tid & 63, wid = __builtin_amdgcn_readfirstlane(tid >> 6), r = lane & 31, hh = lane >> 5;
    constexpr int VSTR = 272;
    const int i16 = lane & 15, tq = i16 >> 2, tp = i16 & 3, tblk = (lane >> 4) & 1;
    const int xq_ = vcu >> 5, xr_ = vcu & 31;
    for (int ui = 0; G > 0 ? (vcu + ui * G < 768) : (ui * (-G) + xr_ < 96); ++ui) {
        const int unit = G > 0 ? vcu + ui * G : 2 * xq_ * 48 + ui * (-G) + xr_;
        const int x = unit & 15; int t1 = unit >> 4; const int g = t1 % 3; t1 /= 3; const int h = t1 & 7, b = t1 >> 3;
        const int lg = 2 * g, dil = 1 << lg, cls = x & (dil - 1), ub = x >> lg;
        const int kbase = 256 * ub - 128;
        const size_t rb = (size_t)b * TP;
        u32x4 vst[12];
        {
            u32x4 kst[12];
#pragma unroll
            for (int i = 0; i < 12; ++i) { const int piece = tid + 512 * i, kl = piece >> 4, part = piece & 15, ki = kbase + kl; kst[i] = (u32x4){0u, 0u, 0u, 0u};
                if (ki >= 0) kst[i] = *(const u32x4*)(K + (rb + (size_t)ki * dil + cls) * 1024 + h * 128 + part * 8); }
#pragma unroll
            for (int i = 0; i < 12; ++i) { const int piece = tid + 512 * i, kl = piece >> 4, part = piece & 15, ki = kbase + kl; vst[i] = (u32x4){0u, 0u, 0u, 0u};
                if (ki >= 0) vst[i] = *(const u32x4*)(V + (rb + (size_t)ki * dil + cls) * 1024 + h * 128 + part * 8); }
#pragma unroll
            for (int i = 0; i < 12; ++i) { const int piece = tid + 512 * i, kl = piece >> 4, part = piece & 15; *(LAS u32x4*)(lds + kl * VSTR + part * 16) = kst[i]; }
        }
        const int q0 = 256 * ub + 32 * wid; const size_t qrow = rb + (size_t)(q0 + r) * dil + cls;
        bf16x8 qf[8];
#pragma unroll
        for (int s = 0; s < 8; ++s) qf[s] = *(const bf16x8*)(Q + qrow * 1024 + h * 128 + 16 * s + 8 * hh);
        __syncthreads();
        f32x16 p[5];
#pragma unroll
        for (int c = 0; c < 5; ++c) {
            const int kb = q0 - 128 + 32 * c;
            if (kb < 0) {
#pragma unroll
                for (int i = 0; i < 16; ++i) p[c][i] = -INFINITY;
            } else {
                LAS const unsigned char* kp = lds + (32 * wid + 32 * c + r) * VSTR + 16 * hh;
                f32x16 acc;
#pragma unroll
                for (int i = 0; i < 16; ++i) acc[i] = 0.f;
#pragma unroll
                for (int s = 0; s < 8; ++s) { const bf16x8 kf = *(LAS const bf16x8*)(kp + 32 * s); acc = MFMA32(kf, qf[s], acc); }
                p[c] = acc;
            }
        }
#pragma unroll
        for (int i = 0; i < 16; ++i) { const int cr = crow(i, hh); if (r > cr) p[0][i] = -INFINITY; if (cr > r) p[4][i] = -INFINITY; }
        float m = -INFINITY;
#pragma unroll
        for (int c = 0; c < 5; ++c)
#pragma unroll
            for (int i = 0; i < 16; ++i) m = fmaxf(m, p[c][i]);
        m = fmaxf(m, __shfl_xor(m, 32));
        float l = 0.f;
#pragma unroll
        for (int c = 0; c < 5; ++c)
#pragma unroll
            for (int i = 0; i < 16; ++i) { const float e = __builtin_amdgcn_exp2f(p[c][i] - m); p[c][i] = e; l += e; }
        l += __shfl_xor(l, 32);
        __syncthreads();
#pragma unroll
        for (int i = 0; i < 12; ++i) { const int piece = tid + 512 * i, kl = piece >> 4, part = piece & 15; *(LAS u32x4*)(lds + kl * VSTR + part * 16) = vst[i]; }
        __syncthreads();
        f32x16 o[4];
#pragma unroll
        for (int d = 0; d < 4; ++d)
#pragma unroll
            for (int i = 0; i < 16; ++i) o[d][i] = 0.f;
#pragma unroll
        for (int c = 0; c < 5; ++c) {
            const int kb = q0 - 128 + 32 * c;
            if (kb >= 0) {
#pragma unroll
                for (int s2 = 0; s2 < 2; ++s2) {
                    u32x4 pw; pw.x = cvtpk(p[c][8 * s2 + 0], p[c][8 * s2 + 1]); pw.y = cvtpk(p[c][8 * s2 + 2], p[c][8 * s2 + 3]); pw.z = cvtpk(p[c][8 * s2 + 4], p[c][8 * s2 + 5]); pw.w = cvtpk(p[c][8 * s2 + 6], p[c][8 * s2 + 7]);
                    const bf16x8 pb = __builtin_bit_cast(bf16x8, pw);
                    LAS const unsigned char* vb = lds + (32 * wid + 32 * c + 16 * s2 + 4 * hh + tq) * VSTR + (16 * tblk + 4 * tp) * 2;
#pragma unroll
                    for (int d = 0; d < 4; ++d) {
                        const v4i16_t lo = tr_read(vb + d * 64), hi = tr_read(vb + 8 * VSTR + d * 64);
                        const bf16x8 va = __builtin_shufflevector(lo, hi, 0, 1, 2, 3, 4, 5, 6, 7);
                        o[d] = MFMA32(va, pb, o[d]);
                    }
                }
            }
        }
        const float inv = 1.0f / l;
        bf16* orow = OG + ((size_t)g * MR + qrow) * 1024 + h * 128;
#pragma unroll
        for (int d = 0; d < 4; ++d)
#pragma unroll
            for (int gi = 0; gi < 4; ++gi) { u32x2 w; w.x = cvtpk(o[d][4 * gi] * inv, o[d][4 * gi + 1] * inv); w.y = cvtpk(o[d][4 * gi + 2] * inv, o[d][4 * gi + 3] * inv);
                *(u32x2*)(orow + 32 * d + 8 * gi + 4 * hh) = w; }
        if (hh == 0) L2G[((size_t)g * MR + qrow) * 8 + h] = m + __builtin_amdgcn_logf(l);
        __syncthreads();
    }
}

__device__ __forceinline__ f32x2 smp_row(const float* cache, const bf16* nb, int b, int s, int h, int dil, int j, int lane) {
    const int idx = 2048 + s - dil * j;
    if (idx >= 2048) { const unsigned w = *(const unsigned*)(nb + (size_t)(MP + b * 8 + (idx - 2048)) * 1024 + h * 128 + 2 * lane); return (f32x2){__uint_as_float(w << 16), __uint_as_float(w & 0xffff0000u)}; }
    return *(const f32x2*)(cache + (((size_t)b * 2048 + idx) * 8 + h) * 128 + 2 * lane);
}
__device__ __forceinline__ const float* smp_base(const float* cache, int b, int s, int h, int lane) {
    const float* p = cache + (((size_t)b * 2048 + 2048 + s) * 8 + h) * 128 + 2 * lane; asm volatile("" : "+v"(p)); return p;
}
__device__ __forceinline__ f32x2 smp_row_cache(const float* base, int dil, int j) { return *(const f32x2*)(base - (size_t)j * dil * 1024); }
__device__ __forceinline__ float reduce16(float (&v)[16], int lane) {
#pragma unroll
    for (int i = 0; i < 8; ++i) { const bool up = lane & 1; const float send = up ? v[i] : v[i + 8], keep = up ? v[i + 8] : v[i]; v[i] = keep + __shfl_xor(send, 1); }
#pragma unroll
    for (int i = 0; i < 4; ++i) { const bool up = lane & 2; const float send = up ? v[i] : v[i + 4], keep = up ? v[i + 4] : v[i]; v[i] = keep + __shfl_xor(send, 2); }
#pragma unroll
    for (int i = 0; i < 2; ++i) { const bool up = lane & 4; const float send = up ? v[i] : v[i + 2], keep = up ? v[i + 2] : v[i]; v[i] = keep + __shfl_xor(send, 4); }
    { const bool up = lane & 8; const float send = up ? v[0] : v[1], keep = up ? v[1] : v[0]; v[0] = keep + __shfl_xor(send, 8); }
    float t = v[0]; t += __shfl_xor(t, 16); t += __shfl_xor(t, 32); return t;
}
template <bool FIRST> __device__ __forceinline__ void smp_batch32(LAS float* sm, const Params& P, const bf16* K, const bf16* V, const float* kbase, const float* vbase, int b, int s, int h, int dil, int j0,
                                                                  f32x2 q2, int lane, int br4, float& M, float& lsum, float& a0, float& a1) {
    f32x2 kr[32], vr[32];
#pragma unroll
    for (int i = 0; i < 32; ++i) kr[i] = (FIRST && i < 8) ? smp_row(P.cache_k, K, b, s, h, dil, i, lane) : smp_row_cache(kbase, dil, j0 + i);
#pragma unroll
    for (int i = 0; i < 32; ++i) vr[i] = (FIRST && i < 8) ? smp_row(P.cache_v, V, b, s, h, dil, i, lane) : smp_row_cache(vbase, dil, j0 + i);
    float v[16], w[16];
#pragma unroll
    for (int i = 0; i < 16; ++i) { v[i] = q2[0] * kr[i][0] + q2[1] * kr[i][1]; w[i] = q2[0] * kr[16 + i][0] + q2[1] * kr[16 + i][1]; }
    const float t0 = reduce16(v, lane), t1 = reduce16(w, lane);
    float mb = fmaxf(t0, t1);
#pragma unroll
    for (int o = 1; o < 16; o <<= 1) mb = fmaxf(mb, __shfl_xor(mb, o));
    const float Mn = fmaxf(M, mb), sc = __builtin_amdgcn_exp2f(M - Mn); a0 *= sc; a1 *= sc; lsum *= sc; M = Mn;
    if (lane < 16) { sm[br4] = __builtin_amdgcn_exp2f(t0 - Mn); sm[16 + br4] = __builtin_amdgcn_exp2f(t1 - Mn); }
    asm volatile("s_waitcnt lgkmcnt(0)" ::: "memory");
#pragma unroll
    for (int i = 0; i < 32; ++i) { const float pj = sm[i]; lsum += pj; a0 += pj * vr[i][0]; a1 += pj * vr[i][1]; }
    asm volatile("s_waitcnt lgkmcnt(0)" ::: "memory");
}
__device__ __forceinline__ void attn_sample_item(LAS float* sm, int item, const Params& P, const bf16* Q, const bf16* K, const bf16* V, bf16* OG, float* L2G, int lane) {
    const int g = item % 3, t1 = item / 3, h = t1 & 7, bs = t1 >> 3, b = bs >> 3, s = bs & 7; const size_t row = MP + bs;
    const int dil = 1 << (2 * g);
    f32x2 q2; { const unsigned qv = *(const unsigned*)(Q + row * 1024 + h * 128 + 2 * lane); q2 = (f32x2){__uint_as_float(qv << 16), __uint_as_float(qv & 0xffff0000u)}; }
    const float* kbase = smp_base(P.cache_k, b, s, h, lane); const float* vbase = smp_base(P.cache_v, b, s, h, lane);
    const int br4 = ((lane & 1) << 3) | ((lane & 2) << 1) | ((lane & 4) >> 1) | ((lane & 8) >> 3);
    float M = -INFINITY, lsum = 0.f, a0 = 0.f, a1 = 0.f;
    smp_batch32<true>(sm, P, K, V, kbase, vbase, b, s, h, dil, 0, q2, lane, br4, M, lsum, a0, a1);
#pragma unroll 1
    for (int jb = 32; jb < 128; jb += 32) smp_batch32<false>(sm, P, K, V, kbase, vbase, b, s, h, dil, jb, q2, lane, br4, M, lsum, a0, a1);
    {
        const f32x2 kr = smp_row_cache(kbase, dil, 128), vr = smp_row_cache(vbase, dil, 128);
        const float t = wave_sum(q2[0] * kr[0] + q2[1] * kr[1]);
        const float Mn = fmaxf(M, t), sc = __builtin_amdgcn_exp2f(M - Mn), pj = __builtin_amdgcn_exp2f(t - Mn);
        a0 = a0 * sc + pj * vr[0]; a1 = a1 * sc + pj * vr[1]; lsum = lsum * sc + pj; M = Mn;
    }
    const float il = 1.0f / lsum;
    *(unsigned*)(OG + ((size_t)g * MR + row) * 1024 + h * 128 + 2 * lane) = cvtpk(a0 * il, a1 * il);
    if (lane == 0) L2G[((size_t)g * MR + row) * 8 + h] = M + __builtin_amdgcn_logf(lsum);
}

__device__ __forceinline__ void merge_conv_phase(const Params& P, const bf16* __restrict__ OG, const float* __restrict__ L2G, const bf16* __restrict__ SZA, const bf16* __restrict__ CH,
                                                 const bf16* __restrict__ GB, bf16* __restrict__ ACT1, int gtid, int ngt) {
    constexpr int NI = MR * 128, UB = 4;
    for (int base = gtid; base < NI; base += UB * ngt) {
        u32x4 ra[UB], rb[UB], rc[UB], rz[UB]; float L0[UB], L1[UB], L2[UB];
#pragma unroll
        for (int u = 0; u < UB; ++u) { const int idx = base + u * ngt; if (idx < NI) { const int row = idx >> 7, cgp = idx & 127, h = cgp >> 4;
            L0[u] = L2G[((size_t)0 * MR + row) * 8 + h]; L1[u] = L2G[((size_t)1 * MR + row) * 8 + h]; L2[u] = L2G[((size_t)2 * MR + row) * 8 + h];
            ra[u] = *(const u32x4*)(OG + ((size_t)0 * MR + row) * 1024 + cgp * 8); rb[u] = *(const u32x4*)(OG + ((size_t)1 * MR + row) * 1024 + cgp * 8);
            rc[u] = *(const u32x4*)(OG + ((size_t)2 * MR + row) * 1024 + cgp * 8); rz[u] = *(const u32x4*)(SZA + (size_t)row * 1024 + cgp * 8); } }
#pragma unroll
        for (int u = 0; u < UB; ++u) { const int idx = base + u * ngt; if (idx < NI) { const int row = idx >> 7, cgp = idx & 127;
            const float M = fmaxf(fmaxf(L0[u], L1[u]), L2[u]); float w0 = __builtin_amdgcn_exp2f(L0[u] - M), w1 = __builtin_amdgcn_exp2f(L1[u] - M), w2 = __builtin_amdgcn_exp2f(L2[u] - M);
            const float iw = 1.0f / (w0 + w1 + w2); w0 *= iw; w1 *= iw; w2 *= iw;
            float a[8], bb[8], c[8], z[8], o[8]; unpack8(ra[u], a); unpack8(rb[u], bb); unpack8(rc[u], c); unpack8(rz[u], z);
#pragma unroll
            for (int e = 0; e < 8; ++e) o[e] = (w0 * a[e] + w1 * bb[e] + w2 * c[e]) * z[e];
            *(u32x4*)(ACT1 + (size_t)row * 2048 + cgp * 8) = pack8(o); } }
    }
    for (int base = gtid; base < NI; base += UB * ngt) {
        u32x4 r0[UB], r1[UB], r2[UB], rg[UB];
#pragma unroll
        for (int u = 0; u < UB; ++u) { const int idx = base + u * ngt; if (idx < NI) { const int row = idx >> 7, c0 = (idx & 127) * 8;
            const int t = row < MP ? (row & 4095) : ((row - MP) & 7);
            r2[u] = *(const u32x4*)(CH + (size_t)row * 1024 + c0); rg[u] = *(const u32x4*)(GB + (size_t)row * 1024 + c0);
            r1[u] = (u32x4){0u, 0u, 0u, 0u}; r0[u] = r1[u];
            if (t >= 1) r1[u] = *(const u32x4*)(CH + (size_t)(row - 1) * 1024 + c0);
            if (t >= 2) r0[u] = *(const u32x4*)(CH + (size_t)(row - 2) * 1024 + c0); } }
#pragma unroll
        for (int u = 0; u < UB; ++u) { const int idx = base + u * ngt; if (idx < NI) { const int row = idx >> 7, c0 = (idx & 127) * 8;
            float u0[8], u1[8], u2[8], gb[8], o[8]; unpack8(r0[u], u0); unpack8(r1[u], u1); unpack8(r2[u], u2); unpack8(rg[u], gb);
            if (row >= MP) { const int t = (row - MP) & 7, bsm = (row - MP) >> 3;
                if (t < 1) {
#pragma unroll
                    for (int e = 0; e < 8; ++e) u1[e] = P.state_conv[((size_t)bsm * 2 + 1) * 1024 + c0 + e];
                }
                if (t < 2) {
#pragma unroll
                    for (int e = 0; e < 8; ++e) u0[e] = P.state_conv[((size_t)bsm * 2 + t) * 1024 + c0 + e];
                }
            }
#pragma unroll
            for (int e = 0; e < 8; ++e) o[e] = gb[e] * (P.conv_w[c0 + e] * u0[e] + P.conv_w[1024 + c0 + e] * u1[e] + P.conv_w[2048 + c0 + e] * u2[e]);
            *(u32x4*)(ACT1 + (size_t)row * 2048 + 1024 + c0) = pack8(o); } }
    }
}
struct Cx { float r, i; };
__device__ __forceinline__ Cx cmul(Cx a, Cx b) { return Cx{a.r * b.r - a.i * b.i, a.r * b.i + a.i * b.r}; }
__device__ __forceinline__ Cx cfma(Cx a, Cx x, Cx y) { return Cx{a.r * x.r - a.i * x.i + y.r, a.r * x.i + a.i * x.r + y.i}; }
__device__ __forceinline__ Cx csel(bool c, Cx a, Cx b) { return Cx{c ? a.r : b.r, c ? a.i : b.i}; }
__device__ __forceinline__ Cx cshfl32(Cx a) { return Cx{__shfl_xor(a.r, 32), __shfl_xor(a.i, 32)}; }

template <bool APPLY> __device__ __forceinline__ void scan_subblock(f32x16& re, f32x16& im, Cx& H, const Cx A1, const Cx A2, const Cx A3, const Cx A4, const bool hi_half) {
    Cx E[4];
#pragma unroll
    for (int gi = 0; gi < 4; ++gi) {
        Cx x{re[4 * gi], im[4 * gi]};
#pragma unroll
        for (int j = 1; j < 4; ++j) { x = cfma(A1, x, Cx{re[4 * gi + j], im[4 * gi + j]}); re[4 * gi + j] = x.r; im[4 * gi + j] = x.i; }
        E[gi] = x;
    }
    Cx cin_own[4]; Cx cin = H;
#pragma unroll
    for (int gi = 0; gi < 4; ++gi) {
        const Cx Eo = cshfl32(E[gi]);
        const Cx e_even = csel(hi_half, Eo, E[gi]), e_odd = csel(hi_half, E[gi], Eo);
        const Cx cin_even = cin; cin = cfma(A4, cin, e_even);
        const Cx cin_odd = cin; cin = cfma(A4, cin, e_odd);
        cin_own[gi] = csel(hi_half, cin_odd, cin_even);
    }
    H = cin;
    if (APPLY) {
#pragma unroll
        for (int gi = 0; gi < 4; ++gi) {
            Cx t;
            t = cmul(A1, cin_own[gi]); re[4 * gi + 0] += t.r; im[4 * gi + 0] += t.i;
            t = cmul(A2, cin_own[gi]); re[4 * gi + 1] += t.r; im[4 * gi + 1] += t.i;
            t = cmul(A3, cin_own[gi]); re[4 * gi + 2] += t.r; im[4 * gi + 2] += t.i;
            t = cmul(A4, cin_own[gi]); re[4 * gi + 3] += t.r; im[4 * gi + 3] += t.i;
        }
    }
}
__device__ __forceinline__ void store_img(LAS unsigned char* img, const f32x16& x, int comp, int hh) {
#pragma unroll
    for (int gi = 0; gi < 4; ++gi) { u32x2 w; w.x = cvtpk(x[4 * gi], x[4 * gi + 1]); w.y = cvtpk(x[4 * gi + 2], x[4 * gi + 3]); *(LAS u32x2*)(img + comp * 64 + 8 * (2 * gi + hh)) = w; }
}

template <int PASS> __device__ __forceinline__ void ssm_prompt_phase(LAS unsigned char* lds, const Params& P, const bf16* __restrict__ U, bf16* __restrict__ YG, const float* __restrict__ SBUF, int vcu, int G) {
    int tid_ = threadIdx.x; asm volatile("" : "+v"(tid_)); const int tid = tid_, lane = tid & 63, wid = __builtin_amdgcn_readfirstlane(tid >> 6), r = lane & 31, hh = lane >> 5;
    const bool hi_half = hh != 0;
    const float* __restrict__ ABAR = (const float*)(P.ws + WS_ABAR); const bf16* __restrict__ BFRAG = (const bf16*)(P.ws + WS_BFRAG); const bf16* __restrict__ CFRAG = (const bf16*)(P.ws + WS_CFRAG);
    LAS unsigned char* img = lds + wid * 8192;
    const int i16 = lane & 15, tq = i16 >> 2, tp = i16 & 3, tblk = (lane >> 4) & 1;
    for (int item = vcu; item < 1024; item += G) {
        const int g8 = item & 15, c = (item >> 4) & 31, b = item >> 9; const int g = g8 * 8 + wid;
        const Cx A1a{ABAR[2 * (g * 64 + r)], ABAR[2 * (g * 64 + r) + 1]}, A1b{ABAR[2 * (g * 64 + 32 + r)], ABAR[2 * (g * 64 + 32 + r) + 1]};
        const Cx A2a = cmul(A1a, A1a), A3a = cmul(A2a, A1a), A4a = cmul(A2a, A2a);
        const Cx A2b = cmul(A1b, A1b), A3b = cmul(A2b, A1b), A4b = cmul(A2b, A2b);
        bf16x8 bfr[4];
#pragma unroll
        for (int k = 0; k < 4; ++k) bfr[k] = *(const bf16x8*)(BFRAG + ((size_t)(g * 4 + k) * 64 + lane) * 8);
        Cx Ha{0.f, 0.f}, Hb{0.f, 0.f};
        if (PASS == 1) {
            Cx Pa = cmul(A4a, A4a), Pb = cmul(A4b, A4b);
#pragma unroll
            for (int k = 0; k < 4; ++k) { Pa = cmul(Pa, Pa); Pb = cmul(Pb, Pb); }
            const Cx Pa2 = cmul(Pa, Pa), Pb2 = cmul(Pb, Pb), Pa4 = cmul(Pa2, Pa2), Pb4 = cmul(Pb2, Pb2);
            const float* sp = SBUF + ((size_t)(b * 128 + g) * 32) * 128;
            const int cq = c >> 2, kq = c & 3;
#pragma unroll 1
            for (int q = 0; q < cq; ++q) {
                const float* s3 = sp + (4 * q + 3) * 128;
                Ha = cfma(Pa4, Ha, Cx{s3[r], s3[64 + r]}); Hb = cfma(Pb4, Hb, Cx{s3[32 + r], s3[96 + r]});
            }
            if (kq > 0) {
                const Cx Pka = kq == 1 ? Pa : (kq == 2 ? Pa2 : cmul(Pa2, Pa)), Pkb = kq == 1 ? Pb : (kq == 2 ? Pb2 : cmul(Pb2, Pb));
                const float* sk = sp + (c - 1) * 128;
                Ha = cfma(Pka, Ha, Cx{sk[r], sk[64 + r]}); Hb = cfma(Pkb, Hb, Cx{sk[32 + r], sk[96 + r]});
            }
        }
        const bf16* up = U + ((size_t)b * TP + c * 128 + r) * DM + 16 * g + 8 * hh;
        bf16x8 unext = *(const bf16x8*)up;
        bf16x8 dfr;
        { const unsigned short dbits = (unsigned short)(cvtpk(r < 16 ? P.d_skip[16 * g + (r & 15)] : 0.f, 0.f) & 0xffffu);
#pragma unroll
          for (int j = 0; j < 8; ++j) dfr[j] = (8 * hh + j == r) ? (short)dbits : (short)0; }
#pragma unroll
        for (int sb = 0; sb < 4; ++sb) {
            const size_t row0 = (size_t)b * TP + c * 128 + sb * 32;
            const bf16x8 ua = unext; if (sb < 3) unext = *(const bf16x8*)(up + (size_t)(sb + 1) * 32 * DM);
            f32x16 z;
#pragma unroll
            for (int i = 0; i < 16; ++i) z[i] = 0.f;
            f32x16 re0 = MFMA32(ua, bfr[0], z), re1 = MFMA32(ua, bfr[1], z), im0 = MFMA32(ua, bfr[2], z), im1 = MFMA32(ua, bfr[3], z);
            scan_subblock<PASS == 1>(re0, im0, Ha, A1a, A2a, A3a, A4a, hi_half);
            scan_subblock<PASS == 1>(re1, im1, Hb, A1b, A2b, A3b, A4b, hi_half);
            if (PASS == 1) {
                store_img(img, re0, r, hh); store_img(img, re1, 32 + r, hh); store_img(img, im0, 64 + r, hh); store_img(img, im1, 96 + r, hh);
                asm volatile("s_waitcnt lgkmcnt(0)" ::: "memory");
                f32x16 y = MFMA32(ua, dfr, z);
#pragma unroll
                for (int s = 0; s < 8; ++s) {
                    const v4i16_t lo = tr_read(img + (16 * s + 8 * hh + tq) * 64 + 8 * (4 * tblk + tp)), hi = tr_read(img + (16 * s + 8 * hh + 4 + tq) * 64 + 8 * (4 * tblk + tp));
                    const bf16x8 xa = __builtin_shufflevector(lo, hi, 0, 1, 2, 3, 4, 5, 6, 7);
                    const bf16x8 cf = *(const bf16x8*)(CFRAG + ((size_t)(g * 8 + s) * 64 + lane) * 8);
                    y = MFMA32(xa, cf, y);
                }
                asm volatile("s_waitcnt lgkmcnt(0)" ::: "memory");
                LAS float* yt = (LAS float*)img;
                if (r < 16) {
#pragma unroll
                    for (int i = 0; i < 16; ++i) yt[crow(i, hh) * 16 + r] = y[i];
                }
                asm volatile("s_waitcnt lgkmcnt(0)" ::: "memory");
                { const int tk = lane >> 1, c8 = (lane & 1) * 8;
                  const f32x4 v0 = *(LAS const f32x4*)(yt + tk * 16 + c8), v1 = *(LAS const f32x4*)(yt + tk * 16 + c8 + 4);
                  float o[8] = {gelu_tanh_f(v0[0]), gelu_tanh_f(v0[1]), gelu_tanh_f(v0[2]), gelu_tanh_f(v0[3]), gelu_tanh_f(v1[0]), gelu_tanh_f(v1[1]), gelu_tanh_f(v1[2]), gelu_tanh_f(v1[3])};
                  *(u32x4*)(YG + (row0 + tk) * DM + 16 * g + c8) = pack8(o); }
                asm volatile("s_waitcnt lgkmcnt(0)" ::: "memory");
            }
        }
        if (PASS == 0) { if (!hi_half) { float* sp = (float*)SBUF + ((size_t)(b * 128 + g) * 32 + c) * 128; sp[r] = Ha.r; sp[64 + r] = Ha.i; sp[32 + r] = Hb.r; sp[96 + r] = Hb.i; } }
        else if (c == 31 && !hi_half) { float* o_re = P.out + OUT_SRP + (size_t)(b * 128 + g) * 64; float* o_im = P.out + OUT_SIP + (size_t)(b * 128 + g) * 64;
            o_re[r] = Ha.r; o_re[32 + r] = Hb.r; o_im[r] = Ha.i; o_im[32 + r] = Hb.i; }
    }
}
__device__ __forceinline__ void ssm_passA_phase(const Params& P, const bf16* __restrict__ U, float* __restrict__ SBUF, int vcu, int G) {
    int tid_ = threadIdx.x; asm volatile("" : "+v"(tid_)); const int tid = tid_, lane = tid & 63, wid = __builtin_amdgcn_readfirstlane(tid >> 6), r = lane & 31, hh = lane >> 5;
    const float* ABAR = (const float*)(P.ws + WS_ABAR); const bf16* BFRAG = (const bf16*)(P.ws + WS_BFRAG);
    for (int item = vcu; item < 256; item += G) {
        const int g8 = item & 15, cq = (item >> 4) & 7, b = item >> 7; const int g = g8 * 8 + wid;
        bf16x8 bfr[4];
#pragma unroll
        for (int k = 0; k < 4; ++k) bfr[k] = *(const bf16x8*)(BFRAG + ((size_t)(g * 4 + k) * 64 + lane) * 8);
        Cx Wt[2][16], A32[2];
#pragma unroll
        for (int st = 0; st < 2; ++st) {
            const int si = g * 64 + 32 * st + r; const Cx A1{ABAR[2 * si], ABAR[2 * si + 1]};
            const Cx A2 = cmul(A1, A1), A3 = cmul(A2, A1), A4 = cmul(A2, A2), A8 = cmul(A4, A4), A16 = cmul(A8, A8); A32[st] = cmul(A16, A16);
            const Cx base = hh ? Cx{1.f, 0.f} : A4;
            Wt[st][15] = base; Wt[st][14] = cmul(base, A1); Wt[st][13] = cmul(base, A2); Wt[st][12] = cmul(base, A3);
#pragma unroll
            for (int i = 11; i >= 0; --i) Wt[st][i] = cmul(Wt[st][i + 4], A8);
        }
        Cx Ha{0.f, 0.f}, Hb{0.f, 0.f};
        const bf16* up = U + ((size_t)b * TP + (size_t)cq * 512 + r) * DM + 16 * g + 8 * hh;
        bf16x8 unext = *(const bf16x8*)up;
#pragma unroll 1
        for (int j = 0; j < 16; ++j) {
            const bf16x8 ua = unext;
            unext = *(const bf16x8*)(up + (size_t)(j < 15 ? j + 1 : 15) * 32 * DM);
            f32x16 z;
#pragma unroll
            for (int i = 0; i < 16; ++i) z[i] = 0.f;
            const f32x16 re0 = MFMA32(ua, bfr[0], z), re1 = MFMA32(ua, bfr[1], z), im0 = MFMA32(ua, bfr[2], z), im1 = MFMA32(ua, bfr[3], z);
            Cx S0[4], S1[4];
#pragma unroll
            for (int q = 0; q < 4; ++q) { S0[q] = Cx{0.f, 0.f}; S1[q] = Cx{0.f, 0.f}; }
#pragma unroll
            for (int i = 0; i < 16; ++i) { S0[i & 3] = cfma(Wt[0][i], Cx{re0[i], im0[i]}, S0[i & 3]); S1[i & 3] = cfma(Wt[1][i], Cx{re1[i], im1[i]}, S1[i & 3]); }
            Cx Sa{(S0[0].r + S0[1].r) + (S0[2].r + S0[3].r), (S0[0].i + S0[1].i) + (S0[2].i + S0[3].i)}, Sb{(S1[0].r + S1[1].r) + (S1[2].r + S1[3].r), (S1[0].i + S1[1].i) + (S1[2].i + S1[3].i)};
            const Cx Sao = cshfl32(Sa), Sbo = cshfl32(Sb);
            Sa.r += Sao.r; Sa.i += Sao.i; Sb.r += Sbo.r; Sb.i += Sbo.i;
            Ha = cfma(A32[0], Ha, Sa); Hb = cfma(A32[1], Hb, Sb);
            if ((j & 3) == 3 && !hh) { float* sp = SBUF + ((size_t)(b * 128 + g) * 32 + 4 * cq + (j >> 2)) * 128; sp[r] = Ha.r; sp[64 + r] = Ha.i; sp[32 + r] = Hb.r; sp[96 + r] = Hb.i; }
        }
    }
}
__device__ __forceinline__ void ssm_sample_item(const Params& P, const bf16* __restrict__ U, bf16* __restrict__ YG, int item, int lane) {
    const int b = item >> 7, g = item & 127, sidx = g * 64 + lane;
    const float* __restrict__ ABAR = (const float*)(P.ws + WS_ABAR); const float* __restrict__ BBRE = (const float*)(P.ws + WS_BBRE); const float* __restrict__ BBIM = (const float*)(P.ws + WS_BBIM);
    const Cx A{ABAR[2 * sidx], ABAR[2 * sidx + 1]};
    float br[16], bi[16], cr[16], ci[16];
#pragma unroll
    for (int k4 = 0; k4 < 4; ++k4) { const f32x4 a = *(const f32x4*)(BBRE + (size_t)sidx * 16 + 4 * k4), c = *(const f32x4*)(BBIM + (size_t)sidx * 16 + 4 * k4);
        br[4 * k4] = a[0]; br[4 * k4 + 1] = a[1]; br[4 * k4 + 2] = a[2]; br[4 * k4 + 3] = a[3]; bi[4 * k4] = c[0]; bi[4 * k4 + 1] = c[1]; bi[4 * k4 + 2] = c[2]; bi[4 * k4 + 3] = c[3]; }
#pragma unroll
    for (int k = 0; k < 16; ++k) { cr[k] = P.c_re[((size_t)g * 16 + k) * 64 + lane]; ci[k] = P.c_im[((size_t)g * 16 + k) * 64 + lane]; }
    Cx H{P.ssm_re[(size_t)(b * 128 + g) * 64 + lane], P.ssm_im[(size_t)(b * 128 + g) * 64 + lane]};
    const int kk = ((lane & 1) << 3) | ((lane & 2) << 1) | ((lane & 4) >> 1) | ((lane & 8) >> 3);
    const float dsk = P.d_skip[16 * g + kk];
    u32x4 ur[8][2];
#pragma unroll
    for (int t = 0; t < 8; ++t) { const size_t off = (size_t)(MP + b * 8 + t) * DM + 16 * g; ur[t][0] = *(const u32x4*)(U + off); ur[t][1] = *(const u32x4*)(U + off + 8); }
#pragma unroll
    for (int t = 0; t < 8; ++t) {
        const size_t off = (size_t)(MP + b * 8 + t) * DM + 16 * g;
        float uu[16]; { float t0[8], t1[8]; unpack8(ur[t][0], t0); unpack8(ur[t][1], t1);
#pragma unroll
            for (int e = 0; e < 8; ++e) { uu[e] = t0[e]; uu[8 + e] = t1[e]; } }
        Cx bu{0.f, 0.f};
#pragma unroll
        for (int k = 0; k < 16; ++k) { bu.r += br[k] * uu[k]; bu.i += bi[k] * uu[k]; }
        H = cfma(A, H, bu);
        float v[16];
#pragma unroll
        for (int k = 0; k < 16; ++k) v[k] = cr[k] * H.r - ci[k] * H.i;
        const float tot = reduce16(v, lane);
        float uk = 0.f;
#pragma unroll
        for (int k = 0; k < 16; ++k) if (kk == k) uk = uu[k];
        if (lane < 16) YG[off + kk] = (bf16)(cvtpk(gelu_tanh_f(tot + dsk * uk), 0.f) & 0xffffu);
    }
    P.out[OUT_SRS + (size_t)(b * 128 + g) * 64 + lane] = H.r; P.out[OUT_SIS + (size_t)(b * 128 + g) * 64 + lane] = H.i;
}

#define XB_TMO      128
#define XB_XCNT(j)  (256  + 64 * (j))
#define XB_XSUB(j)  (1280 + 64 * (j))
#define XB_XGEN(j)  (2304 + 64 * (j))
#define XB_TOP      3328
#define XB_TOPGEN   3392
#define XCD_BAR_WORDS 3456
#define XB_SPIN_CAP (1u << 18)

__device__ __forceinline__ unsigned xb_ld(unsigned* p)              { return __hip_atomic_load(p, __ATOMIC_RELAXED, __HIP_MEMORY_SCOPE_AGENT); }
__device__ __forceinline__ unsigned xb_add(unsigned* p, unsigned v) { return __hip_atomic_fetch_add(p, v, __ATOMIC_RELAXED, __HIP_MEMORY_SCOPE_AGENT); }
__device__ __forceinline__ unsigned xb_xcc_id() { return (unsigned)__builtin_amdgcn_s_getreg((3 << 11) | 20) & 0xFu; }
#define XB_SPIN(cond, bar) do { unsigned _sp = 0; while (cond) { __builtin_amdgcn_s_sleep(1); \
    if ((++_sp & 255u) == 0u) { if (xb_ld(&(bar)[XB_TMO])) break; if (_sp > XB_SPIN_CAP) { atomicAdd(&(bar)[XB_TMO], 1u); break; } } } } while (0)

struct XcdBarrier {
    unsigned* bar; unsigned x;
    volatile LAS unsigned* st;
};

__device__ __forceinline__ XcdBarrier xcd_barrier_post(unsigned* bar, volatile LAS unsigned* st) {
    XcdBarrier b; b.bar = bar; b.x = xb_xcc_id(); b.st = st;
    if (threadIdx.x == 0) (void)xb_add(&bar[XB_XCNT(b.x)], 1u);
    return b;
}
__device__ __forceinline__ void xcd_barrier_complete(unsigned* bar, unsigned x, unsigned& nloc, unsigned& nx) {
    const unsigned G = gridDim.x * gridDim.y * gridDim.z;
    unsigned sum, cnt, mine, sp = 0u;
    for (;;) {
        sum = 0u; cnt = 0u; mine = 0u;
#pragma unroll
        for (unsigned j = 0; j < 16; ++j) { const unsigned c = xb_ld(&bar[XB_XCNT(j)]); sum += c; cnt += (c > 0u) ? 1u : 0u; mine = (j == x) ? c : mine; }
        if (sum == G) break;
        __builtin_amdgcn_s_sleep(1);
        if ((++sp & 255u) == 0u) { if (xb_ld(&bar[XB_TMO])) break; if (sp > XB_SPIN_CAP) { atomicAdd(&bar[XB_TMO], 1u); break; } }
    }
    nloc = mine > 0u ? mine : 1u; nx = cnt > 0u ? cnt : 1u;
}

__device__ __forceinline__ void xcd_barrier(const XcdBarrier& b) {
    asm volatile("s_waitcnt vmcnt(0)" ::: "memory");
    __syncthreads();
    if (threadIdx.x == 0) {
        unsigned* bar = b.bar;
        __builtin_amdgcn_s_waitcnt(0);
        unsigned nloc = b.st[0], nx = b.st[1];
        if (nloc == 0u) { xcd_barrier_complete(bar, b.x, nloc, nx); b.st[0] = nloc; b.st[1] = nx; }
        const unsigned old = xb_add(&bar[XB_XSUB(b.x)], 1u);
        const unsigned gen = old / nloc;
        if (old + 1u == (gen + 1u) * nloc) {
            __builtin_amdgcn_fence(__ATOMIC_RELEASE, "agent");
            asm volatile("s_waitcnt vmcnt(0)" ::: "memory");
            const unsigned og = xb_add(&bar[XB_TOP], 1u);
            const unsigned tg = og / nx;
            if (og + 1u == (tg + 1u) * nx) xb_add(&bar[XB_TOPGEN], 1u);
            else XB_SPIN(xb_ld(&bar[XB_TOPGEN]) == tg, bar);
            __builtin_amdgcn_fence(__ATOMIC_ACQUIRE, "agent");
            xb_add(&bar[XB_XGEN(b.x)], 1u);
            asm volatile("s_waitcnt vmcnt(0)" ::: "memory");
        } else {
            XB_SPIN(xb_ld(&bar[XB_XGEN(b.x)]) == gen, bar);
            __builtin_amdgcn_fence(__ATOMIC_ACQUIRE, "agent");
            asm volatile("s_waitcnt vmcnt(0)" ::: "memory");
        }
    }
    __syncthreads();
}

#define AS4 __attribute__((address_space(4)))
__device__ __forceinline__ Params load_params() {
    typedef const float* cfp;
    const AS4 cfp* ka = (const AS4 cfp*)__builtin_amdgcn_kernarg_segment_ptr();
    asm volatile("" : "+s"(ka));
    Params q;
    q.x_prompt = ka[0]; q.x_sample = ka[1]; q.cache_k = ka[2]; q.cache_v = ka[3]; q.state_conv = ka[4]; q.ssm_re = ka[5]; q.ssm_im = ka[6]; q.attn_norm = ka[7]; q.w_in_ab = ka[8];
    q.conv_w = ka[9]; q.w_out_ab = ka[10]; q.ssm_norm = ka[11]; q.w_in_c = ka[12]; q.lam_re = ka[13]; q.lam_im = ka[14]; q.log_step = ka[15]; q.b_re = ka[16]; q.b_im = ka[17];
    q.c_re = ka[18]; q.c_im = ka[19]; q.d_skip = ka[20]; q.w_glu = ka[21]; q.b_glu = ka[22]; q.w_out_c = ka[23]; q.final_norm = ka[24]; q.out = (float*)ka[25]; q.ws = (unsigned char*)ka[26];
    return q;
}
#define PHASE_VARS const Params P = load_params(); unsigned char* ws = P.ws; bf16* X0 = (bf16*)(ws + WS_A); bf16* ACT1 = X0; bf16* U = X0; bf16* Qb = (bf16*)(ws + WS_B); bf16* Kb = (bf16*)(ws + WS_B + HALF_SLOT); bf16* H1b = Qb; bf16* YG = (bf16*)(ws + WS_OG); bf16* Vb = (bf16*)(ws + WS_C); bf16* SZA = (bf16*)(ws + WS_C + HALF_SLOT); bf16* ZS = Vb; bf16* CH = (bf16*)(ws + WS_D); bf16* GB = (bf16*)(ws + WS_D + HALF_SLOT); bf16* ACT2 = CH; bf16* OG = (bf16*)(ws + WS_OG); float* L2G = (float*)(ws + WS_L2G); float* SBUF = (float*)(ws + WS_SBUF); float* rs0 = (float*)(ws + WS_RS0); float* rss1 = (float*)(ws + WS_RSS1); float* rss2 = (float*)(ws + WS_RSS2); const bf16* W1 = (const bf16*)(ws + WS_W1); const bf16* W2 = (const bf16*)(ws + WS_W2); const bf16* W3 = (const bf16*)(ws + WS_W3); const bf16* W4 = (const bf16*)(ws + WS_W4); const bf16* W5 = (const bf16*)(ws + WS_W5);
__global__ void __launch_bounds__(NTHREADS) fwd_megakernel(Params Pk) {
    extern __shared__ __attribute__((aligned(16))) unsigned char lds_raw[];
    LAS unsigned char* lds = (LAS unsigned char*)lds_raw;
    int tid_ = threadIdx.x; asm volatile("" : "+v"(tid_)); const int tid = tid_, lane = tid & 63, wave = __builtin_amdgcn_readfirstlane(tid >> 6);
    const int G = gridDim.x, bx = blockIdx.x; const int vcu = (G % 8 == 0) ? (bx % 8) * (G / 8) + bx / 8 : bx;
    const int gw = vcu * NWAVES + wave, NGW = G * NWAVES;
    unsigned* barw = (unsigned*)(Pk.ws + WS_BAR);
    volatile LAS unsigned* bar_st = (volatile LAS unsigned*)(lds + 131072);
    if (tid < 2) bar_st[tid] = 0u;
    __syncthreads();
    XcdBarrier xbar = xcd_barrier_post(barw, bar_st);
#ifndef ONLY_PHASE
#define PH(k) true
#else
#define PH(k) ((k)==ONLY_PHASE)
#endif
#define GSYNC() do { xcd_barrier(xbar); if (REP_PHASE == 100) { xcd_barrier(xbar); xcd_barrier(xbar); } } while (0)
#define RUNP(k, ...) do { { PHASE_VARS __VA_ARGS__ } GSYNC(); if ((k) == REP_PHASE) { { PHASE_VARS __VA_ARGS__ } GSYNC(); } } while (0)
    { PHASE_VARS if (PH(0)) p0_prologue(P, lds, gw, NGW, lane, wave); }
    GSYNC();
    if (REP_PHASE == 0) { { PHASE_VARS if (PH(0)) p0_prologue(P, lds, gw, NGW, lane, wave); } GSYNC(); }
    RUNP(1, if (PH(1)) { E1 e{Qb, Kb, Vb, SZA, CH, GB, rs0, (const float*)(ws + WS_ROPE), P.out}; gemm_all<E1, false>(lds, X0, W1, 8192, e, nullptr, vcu, G); });
    RUNP(2, if (G == 256) {
                const int xq = vcu >> 5, xr = vcu & 31;
                if (xr >= 20) { const int wq = (xr - 20) * 8 + wave;
                    _Pragma("unroll 1") for (int it = 0; it < (REP_PHASE == 22 ? 4 : 2); ++it) { const int combo = (wq >> 3) + 12 * (it & 1), hq = combo & 7, gq = combo >> 3, sq = wq & 7;
                        attn_sample_item((LAS float*)(lds + 104448 + wave * 1024), ((xq * 8 + sq) * 8 + hq) * 3 + gq, P, Qb, Kb, Vb, OG, L2G, lane); } }
                else { attn_prompt_phase(lds, Qb, Kb, Vb, OG, L2G, vcu, -20); if (REP_PHASE == 23) attn_prompt_phase(lds, Qb, Kb, Vb, OG, L2G, vcu, -20); }
            } else {
                if (gw < 1536) attn_sample_item((LAS float*)(lds + 104448 + wave * 1024), gw, P, Qb, Kb, Vb, OG, L2G, lane);
                attn_prompt_phase(lds, Qb, Kb, Vb, OG, L2G, vcu, G);
            });
    RUNP(4, if (PH(4)) merge_conv_phase(P, OG, L2G, SZA, CH, GB, ACT1, gw * 64 + lane, NGW * 64););
    RUNP(-5, if (PH(5)) { E2 e{P.x_prompt, P.x_sample, H1b}; gemm_all<E2, true>(lds, ACT1, W2, 2048, e, rss1, vcu, G); });
    RUNP(6, if (PH(6)) { E3 e{rss1, U, ZS}; gemm_all<E3, false>(lds, H1b, W3, 4096, e, nullptr, vcu, G); });
    RUNP(7, if (PH(7)) ssm_passA_phase(P, U, SBUF, vcu, G);
            if (PH(8)) for (int it = gw; it < 1024; it += NGW) ssm_sample_item(P, U, YG, it, lane););
    RUNP(9, if (PH(9)) ssm_prompt_phase<1>(lds, P, U, YG, SBUF, vcu, G););
    RUNP(10, if (PH(10)) { E4 e{YG, ZS, P.b_glu, ACT2}; gemm_all<E4, false>(lds, YG, W4, 2048, e, nullptr, vcu, G); });
    if (G == 256) { PHASE_VARS if (PH(11)) gemm5_fused(lds, ACT2, W5, H1b, P.out, rss2, (unsigned*)(ws + WS_CNT), P.final_norm, vcu, G); return; }
    RUNP(-11, if (PH(11)) { E5 e{H1b, P.out}; gemm_all<E5, true>(lds, ACT2, W5, 2048, e, rss2, vcu, G); });
    if (PH(12)) {
        PHASE_VARS
        const int gt = gw * 64 + lane, ngt = NGW * 64; constexpr int NI = MR * 512, UB = 4;
        float* __restrict__ outp = P.out; const float* __restrict__ fn = P.final_norm; const float* __restrict__ r2p = rss2;
        for (int base = gt; base < NI; base += UB * ngt) {
            f32x4 v[UB]; float rq[UB];
#pragma unroll
            for (int u = 0; u < UB; ++u) { const int idx = base + u * ngt; if (idx < NI) { v[u] = *(const f32x4*)(outp + (size_t)idx * 4); rq[u] = r2p[idx >> 9]; } }
#pragma unroll
            for (int u = 0; u < UB; ++u) { const int idx = base + u * ngt; if (idx < NI) { const int c4 = (idx & 511) * 4;
                const float rs = 1.0f / sqrtf(rq[u] * (1.0f / DM) + RMS_EPS); const f32x4 gg = *(const f32x4*)(fn + c4); f32x4 w = v[u];
                w[0] *= rs * gg[0]; w[1] *= rs * gg[1]; w[2] *= rs * gg[2]; w[3] *= rs * gg[3];
                *(f32x4*)(outp + (size_t)idx * 4) = w; } }
        }
    }
}

extern "C" void kernel_launch(void* const* d_in, const int* in_sizes, int n_in, void* d_out, int out_size, void* d_ws, size_t ws_size, hipStream_t stream) {
    static int grid_blocks = 0;
    if (grid_blocks == 0) {
        if (n_in != 25 || ws_size < WS_END) { fprintf(stderr, "kernel_launch: unexpected n_in %d / ws_size %zu\n", n_in, ws_size); grid_blocks = -1; return; }
        int dev = 0, cus = 0, per_cu = 0;
        hipGetDevice(&dev); hipDeviceGetAttribute(&cus, hipDeviceAttributeMultiprocessorCount, dev);
        hipFuncSetAttribute((const void*)fwd_megakernel, hipFuncAttributeMaxDynamicSharedMemorySize, LDS_BYTES);
        hipOccupancyMaxActiveBlocksPerMultiprocessor(&per_cu, (const void*)fwd_megakernel, NTHREADS, LDS_BYTES);
        if (per_cu < 1) { fprintf(stderr, "kernel_launch: occupancy query says %d blocks per CU\n", per_cu); per_cu = 1; }
        (void)hipGetLastError();
        grid_blocks = cus;
    }
    if (grid_blocks < 0) return;
    if (hipMemsetAsync((char*)d_ws + WS_BAR, 0, (WS_CNT - WS_BAR) + 64 * 48 * 4, stream) != hipSuccess) { fprintf(stderr, "kernel_launch: memset of the barrier words failed\n"); return; }
    Params p{};
    const float** pp = (const float**)&p;
    for (int i = 0; i < 25; ++i) pp[i] = (const float*)d_in[i];
    p.out = (float*)d_out; p.ws = (unsigned char*)d_ws;
    void* args[] = {&p};
    hipError_t e = hipLaunchCooperativeKernel((const void*)fwd_megakernel, dim3(grid_blocks), dim3(NTHREADS), args, LDS_BYTES, stream);
    if (e != hipSuccess) fprintf(stderr, "cooperative launch failed: %s (grid %d)\n", hipGetErrorString(e), grid_blocks);
}
```

```cpp
#include <hip/hip_runtime.h>
#include <hip/hip_cooperative_groups.h>
#include <cstdio>
#include <cstdint>
namespace cg = cooperative_groups;
#ifndef REP_PHASE
#define REP_PHASE -1
#endif
namespace pg8 {
#define PG8_LAS __attribute__((address_space(3)))
typedef unsigned short bf16_t;
typedef short bf16x8 __attribute__((ext_vector_type(8)));
typedef float f32x4 __attribute__((ext_vector_type(4)));
typedef unsigned u32x4 __attribute__((ext_vector_type(4)));
constexpr int BM = 256, BK = 64, HALF = 128, HTB = HALF * BK * 2  , STAGE_BYTES = 8 * HTB, NXCD = 8, WGM = 8;

__host__ __device__ __forceinline__ int lds_byte(int r, int c) { const int st = (r >> 4) * 2 + (c >> 5), rr = r & 15, cc = c & 31, ob = rr * 64 + cc * 2; return st * 1024 + (ob ^ (((ob >> 9) & 1) << 5)); }
__host__ __device__ __forceinline__ void stage_rc(int b, int& R, int& C) { const int st = b / 1024, sb = b % 1024, swz = sb ^ (((sb >> 9) & 1) << 5); R = (st >> 1) * 16 + swz / 64; C = (st & 1) * 32 + (swz % 64) / 2; }
__host__ __device__ __forceinline__ int perm32(int rho) { const int n = rho >> 4, i = rho & 15; return 8 * (i >> 2) + 4 * n + (i & 3); }

struct Unit { int pm, pn; };
struct Gemm { const bf16_t* A; const bf16_t* Bt; int M, N, K; };

struct StaticOrder {
    int nM, nN, nwg, G, c;
    __host__ __device__ void init(int M, int N, int G_, int c_) { nM = M / BM; nN = N / BM; nwg = nM * nN; G = G_; c = c_; }
    __host__ __device__ bool next(int i, Unit& u) const {
        const long L = (long)i * G + c; if (L >= nwg) return false;
        int wgid = (int)L; { const int q = nwg / NXCD, r = nwg % NXCD, xcd = wgid % NXCD, off = wgid / NXCD; wgid = (xcd < r ? xcd * (q + 1) : r * (q + 1) + (xcd - r) * q) + off; }
        const int nig = WGM * nN, gid = wgid / nig, fm = gid * WGM, gsz = (nM - fm) < WGM ? (nM - fm) : WGM;
        u.pm = fm + ((wgid % nig) % gsz); u.pn = (wgid % nig) / gsz; return true;
    }
    __device__ __forceinline__ void a_ready(const Unit&) const {}
    __device__ __forceinline__ void done(const Unit&) const {}
};

__device__ __forceinline__ unsigned cvt_pk_bf16(float lo, float hi) { unsigned r; asm volatile("v_cvt_pk_bf16_f32 %0, %1, %2" : "=v"(r) : "v"(lo), "v"(hi)); return r; }
typedef float f32x2 __attribute__((ext_vector_type(2)));
template <class Epi, class Sched, bool ALIGN_EPI = false, bool SP2 = false>
__device__ __forceinline__ void gemm_phase(PG8_LAS unsigned char* lds, const Gemm g, const Sched& S, const Epi& E) {
    int tid_ = threadIdx.x; asm volatile("" : "+v"(tid_)); const int tid = tid_, wid = __builtin_amdgcn_readfirstlane(tid >> 6), lane = tid & 63, wr = wid >> 2, wc = wid & 3, fr = lane & 15, fq = lane >> 4;
    const int K = g.K, nt = K / BK;
    unsigned voffA[2], voffB[2];
#pragma unroll
    for (int i = 0; i < 2; ++i) { int R, C; stage_rc(tid * 16 + i * 8192, R, C); const int Rb = Epi::PERM ? ((R & ~31) + perm32(R & 31)) : R;
        voffA[i] = (unsigned)(R * K + C) * 2u; voffB[i] = (unsigned)(Rb * K + C) * 2u; }
    const size_t kstep = (size_t)(BK * 2);
    const size_t hstep = (size_t)HALF * K * 2;
    const size_t tstep = 2 * hstep;
    const unsigned ldsw = (unsigned)wid * 1024u;
    const int aoff = lds_byte(wr * 64 + fr, fq * 8), boff = lds_byte(wc * 32 + fr, fq * 8);
#define PG8_SA(b, h) (((b) * 2 + (h)) * HTB)
#define PG8_SB(b, h) ((4 + (b) * 2 + (h)) * HTB)
#define PG8_STAGE(bufoff, gbase, voff) do { _Pragma("unroll") for (int _i = 0; _i < 2; ++_i) \
        __builtin_amdgcn_global_load_lds((const unsigned*)((const char*)(gbase) + (voff)[_i]), (PG8_LAS unsigned*)(lds + (bufoff) + ldsw + _i * 8192), 16, 0, 0); } while (0)
#define PG8_LDA(dst, b, h) do { _Pragma("unroll") for (int m = 0; m < 4; ++m) _Pragma("unroll") for (int k = 0; k < 2; ++k) dst[m][k] = *(const PG8_LAS bf16x8*)(lds + PG8_SA(b, h) + aoff + m * 2048 + k * 1024); } while (0)
#define PG8_LDB(dst, b, h) do { _Pragma("unroll") for (int n = 0; n < 2; ++n) _Pragma("unroll") for (int k = 0; k < 2; ++k) dst[n][k] = *(const PG8_LAS bf16x8*)(lds + PG8_SB(b, h) + boff + n * 2048 + k * 1024); } while (0)
#define PG8_MMA(ai, bj, At, Bt) do { __builtin_amdgcn_s_setprio(1); _Pragma("unroll") for (int m = 0; m < 4; ++m) _Pragma("unroll") for (int n = 0; n < 2; ++n) _Pragma("unroll") for (int k = 0; k < 2; ++k) \
        acc[ai][bj][m][n] = __builtin_amdgcn_mfma_f32_16x16x32_bf16(Bt[n][k], At[m][k], acc[ai][bj][m][n], 0, 0, 0); __builtin_amdgcn_s_setprio(0); } while (0)
#define PG8_WAIT_V(n) asm volatile("s_waitcnt vmcnt(" #n ")" ::: "memory")
#define PG8_WAIT_L(n) asm volatile("s_waitcnt lgkmcnt(" #n ")" ::: "memory")
#define PG8_BAR __builtin_amdgcn_s_barrier()
#define PG8_SCHED __builtin_amdgcn_sched_barrier(0)
    Unit cur, nxt; int ui = 0;
    if (!S.next(0, cur)) return;
    f32x4 acc[2][2][4][2];
#pragma unroll
    for (int a = 0; a < 2; ++a)
#pragma unroll
        for (int b = 0; b < 2; ++b)
#pragma unroll
            for (int m = 0; m < 4; ++m)
#pragma unroll
                for (int n = 0; n < 2; ++n) acc[a][b][m][n] = (f32x4){0.f, 0.f, 0.f, 0.f};
    bf16x8 At[4][2], B0[2][2], B1[2][2];
    const char* cA = (const char*)g.A + (size_t)cur.pm * tstep; const char* cB = (const char*)g.Bt + (size_t)cur.pn * tstep;
    S.a_ready(cur);
    if constexpr (SP2) {
        PG8_STAGE(PG8_SB(0, 0), cB, voffB); PG8_STAGE(PG8_SB(0, 1), cB + hstep, voffB); PG8_STAGE(PG8_SA(0, 0), cA, voffA); PG8_STAGE(PG8_SA(0, 1), cA + hstep, voffA);
        if (wr == 1) PG8_BAR;
        PG8_WAIT_V(2); PG8_BAR;
        PG8_STAGE(PG8_SB(1, 0), cB + kstep, voffB); PG8_STAGE(PG8_SA(1, 0), cA + kstep, voffA); PG8_STAGE(PG8_SB(1, 1), cB + hstep + kstep, voffB);
        PG8_WAIT_V(6); PG8_BAR;
    } else {
        PG8_STAGE(PG8_SB(0, 0), cB, voffB); PG8_STAGE(PG8_SA(0, 0), cA, voffA); PG8_STAGE(PG8_SB(0, 1), cB + hstep, voffB); PG8_STAGE(PG8_SA(0, 1), cA + hstep, voffA);
        if (wr == 1) PG8_BAR;
        PG8_WAIT_V(4); PG8_BAR;
        PG8_STAGE(PG8_SB(1, 0), cB + kstep, voffB); PG8_STAGE(PG8_SA(1, 0), cA + kstep, voffA); PG8_STAGE(PG8_SB(1, 1), cB + hstep + kstep, voffB);
        PG8_WAIT_V(6); PG8_BAR;
    }
    for (;;) {
        const bool has_next = S.next(ui + 1, nxt);
        const char* nA = has_next ? (const char*)g.A + (size_t)nxt.pm * tstep : cA; const char* nB = has_next ? (const char*)g.Bt + (size_t)nxt.pn * tstep : cB;
        for (int t = 0; t < nt; t += 2) {
            const bool last = (t == nt - 2);
            const char* a1 = cA + (size_t)(t + 1) * kstep;
            const char* a2 = last ? nA : cA + (size_t)(t + 2) * kstep; const char* b2 = last ? nB : cB + (size_t)(t + 2) * kstep;
            const char* a3 = a2 + kstep; const char* b3 = b2 + kstep;
            if (last && has_next) S.a_ready(nxt);
            if constexpr (SP2) {
            PG8_LDB(B0, 0, 0); PG8_LDB(B1, 0, 1); PG8_SCHED; PG8_LDA(At, 0, 0); PG8_STAGE(PG8_SA(1, 1), a1 + hstep, voffA);
            PG8_WAIT_V(8); PG8_WAIT_L(0); PG8_BAR; PG8_MMA(0, 0, At, B0); PG8_MMA(0, 1, At, B1); PG8_BAR; PG8_SCHED;
            PG8_LDA(At, 0, 1); PG8_STAGE(PG8_SB(0, 0), b2, voffB); PG8_STAGE(PG8_SB(0, 1), b2 + hstep, voffB); PG8_STAGE(PG8_SA(0, 0), a2, voffA);
            PG8_WAIT_V(8); PG8_WAIT_L(0); PG8_BAR; PG8_MMA(1, 0, At, B0); PG8_MMA(1, 1, At, B1); PG8_BAR; PG8_SCHED;
            PG8_LDB(B0, 1, 0); PG8_LDB(B1, 1, 1); PG8_SCHED; PG8_LDA(At, 1, 0); PG8_STAGE(PG8_SA(0, 1), a2 + hstep, voffA);
            PG8_WAIT_V(8); PG8_WAIT_L(0); PG8_BAR; PG8_MMA(0, 0, At, B0); PG8_MMA(0, 1, At, B1); PG8_BAR; PG8_SCHED;
            PG8_LDA(At, 1, 1); PG8_STAGE(PG8_SB(1, 0), b3, voffB); PG8_STAGE(PG8_SB(1, 1), b3 + hstep, voffB); PG8_STAGE(PG8_SA(1, 0), a3, voffA);
            PG8_WAIT_V(8); PG8_WAIT_L(0); PG8_BAR; PG8_MMA(1, 0, At, B0); PG8_MMA(1, 1, At, B1); PG8_BAR; PG8_SCHED;
            } else {
            PG8_LDB(B0, 0, 0); PG8_SCHED; PG8_LDA(At, 0, 0); PG8_STAGE(PG8_SA(1, 1), a1 + hstep, voffA);
            PG8_WAIT_L(8); PG8_BAR; PG8_WAIT_L(0); PG8_MMA(0, 0, At, B0); PG8_BAR; PG8_SCHED;
            PG8_LDB(B1, 0, 1); PG8_STAGE(PG8_SB(0, 0), b2, voffB);
            PG8_BAR; PG8_WAIT_L(0); PG8_MMA(0, 1, At, B1); PG8_BAR;
            PG8_LDA(At, 0, 1); PG8_STAGE(PG8_SA(0, 0), a2, voffA);
            PG8_BAR; PG8_WAIT_L(0); PG8_MMA(1, 0, At, B0); PG8_BAR; PG8_SCHED;
            PG8_STAGE(PG8_SB(0, 1), b2 + hstep, voffB);
            PG8_WAIT_V(6); PG8_BAR; PG8_MMA(1, 1, At, B1); PG8_BAR;
            PG8_LDB(B0, 1, 0); PG8_SCHED; PG8_LDA(At, 1, 0); PG8_STAGE(PG8_SA(0, 1), a2 + hstep, voffA);
            PG8_WAIT_L(8); PG8_BAR; PG8_WAIT_L(0); PG8_MMA(0, 0, At, B0); PG8_BAR; PG8_SCHED;
            PG8_LDB(B1, 1, 1); PG8_STAGE(PG8_SB(1, 0), b3, voffB);
            PG8_BAR; PG8_WAIT_L(0); PG8_MMA(0, 1, At, B1); PG8_BAR;
            PG8_LDA(At, 1, 1); PG8_STAGE(PG8_SA(1, 0), a3, voffA);
            PG8_BAR; PG8_WAIT_L(0); PG8_MMA(1, 0, At, B0); PG8_BAR; PG8_SCHED;
            PG8_STAGE(PG8_SB(1, 1), b3 + hstep, voffB);
            PG8_WAIT_V(6); PG8_BAR; PG8_MMA(1, 1, At, B1); PG8_BAR;
            }
        }
        if constexpr (ALIGN_EPI) { if (wr == 0) PG8_BAR; }
        if constexpr (!Epi::AFTER_DRAIN) { E(acc, cur, wr, wc, fr, fq); S.done(cur); }
        if (!has_next) break;
#pragma unroll
        for (int a = 0; a < 2; ++a)
#pragma unroll
            for (int b = 0; b < 2; ++b)
#pragma unroll
                for (int m = 0; m < 4; ++m)
#pragma unroll
                    for (int n = 0; n < 2; ++n) acc[a][b][m][n] = (f32x4){0.f, 0.f, 0.f, 0.f};
        cur = nxt; cA = nA; cB = nB; ++ui;
        if constexpr (ALIGN_EPI) { if (wr == 1) PG8_BAR; }
    }
    PG8_WAIT_V(0);
    if constexpr (!ALIGN_EPI) { if (wr == 0) PG8_BAR; }
    PG8_BAR;
    if constexpr (Epi::AFTER_DRAIN) { E.fused(acc, cur, wr, wc, fr, fq, lds, wid, lane); S.done(cur); }
#undef PG8_SA
#undef PG8_SB
#undef PG8_STAGE
#undef PG8_LDA
#undef PG8_LDB
#undef PG8_MMA
#undef PG8_WAIT_V
#undef PG8_WAIT_L
#undef PG8_BAR
#undef PG8_SCHED
}
}
#define LAS __attribute__((address_space(3)))
typedef unsigned short bf16;
typedef unsigned u32x4 __attribute__((ext_vector_type(4)));
typedef unsigned u32x2 __attribute__((ext_vector_type(2)));
typedef float f32x2 __attribute__((ext_vector_type(2)));
typedef float f32x16 __attribute__((ext_vector_type(16)));
typedef __bf16 bf16x2_t __attribute__((ext_vector_type(2)));
typedef short v4i16_t __attribute__((ext_vector_type(4)));
using pg8::f32x4; using pg8::bf16x8;

constexpr int DM = 2048, TP = 4096, MP = 8192, MS = 64, MR = 8256;
constexpr float RMS_EPS = 1e-6f;
constexpr float LOG2E = 1.4426950408889634f;
constexpr float C2 = 0.08838834764831845f * 1.4426950408889634f;
constexpr int NTHREADS = 512, NWAVES = 8;
constexpr int LDS_BYTES = 131072 + 256;

constexpr size_t OUT_KP = 16908288, OUT_VP = OUT_KP + 4194304, OUT_CP = OUT_VP + 4194304, OUT_SRP = OUT_CP + 4096, OUT_SIP = OUT_SRP + 16384,
                 OUT_KS = OUT_SIP + 16384, OUT_VS = OUT_KS + 65536, OUT_CS = OUT_VS + 65536, OUT_SRS = OUT_CS + 16384, OUT_SIS = OUT_SRS + 65536;
constexpr size_t KiB = 1024, MiB = 1u << 20;
constexpr size_t WS_RS0 = 0, WS_RSS1 = 64 * KiB, WS_RSS2 = 128 * KiB, WS_ABAR = 192 * KiB, WS_BBRE = 256 * KiB, WS_BBIM = 768 * KiB,
                 WS_BFRAG = 1280 * KiB, WS_CFRAG = 1792 * KiB, WS_ROPE = 2816 * KiB, WS_L2G = 5 * MiB, WS_BAR = 5 * MiB + 896 * KiB, WS_CNT = 5 * MiB + 960 * KiB, WS_SBUF = 6 * MiB;
constexpr size_t WS_W1 = 10 * MiB, WS_W2 = 42 * MiB, WS_W3 = 50 * MiB, WS_W4 = 66 * MiB, WS_W5 = 74 * MiB;
constexpr size_t WS_A = 82 * MiB, WS_B = 115 * MiB, WS_C = 148 * MiB, WS_D = 181 * MiB, WS_OG = 214 * MiB, WS_END = 263 * MiB;
constexpr size_t HALF_SLOT = (size_t)MR * 1024 * 2;

__device__ __forceinline__ float bf2f(unsigned short b) { return __uint_as_float(((unsigned)b) << 16); }
__device__ __forceinline__ unsigned cvtpk(float lo, float hi) { f32x2 v = {lo, hi}; bf16x2_t b = __builtin_convertvector(v, bf16x2_t); return __builtin_bit_cast(unsigned, b); }
__device__ __forceinline__ void unpack8(const u32x4 w, float (&f)[8]) {
#pragma unroll
    for (int i = 0; i < 4; ++i) { f[2 * i] = __uint_as_float(w[i] << 16); f[2 * i + 1] = __uint_as_float(w[i] & 0xffff0000u); }
}
__device__ __forceinline__ u32x4 pack8(const float (&f)[8]) { u32x4 w; w.x = cvtpk(f[0], f[1]); w.y = cvtpk(f[2], f[3]); w.z = cvtpk(f[4], f[5]); w.w = cvtpk(f[6], f[7]); return w; }
__device__ __forceinline__ float wave_sum(float v) {
#pragma unroll
    for (int o = 1; o < 64; o <<= 1) v += __shfl_xor(v, o);
    return v;
}
__device__ __forceinline__ float wave_max(float v) {
#pragma unroll
    for (int o = 1; o < 64; o <<= 1) v = fmaxf(v, __shfl_xor(v, o));
    return v;
}
__device__ __forceinline__ float sigmoid_f(float x) { return __builtin_amdgcn_rcpf(1.0f + __builtin_amdgcn_exp2f(-x * LOG2E)); }
__device__ __forceinline__ float silu_f(float x) { return x * sigmoid_f(x); }
__device__ __forceinline__ float gelu_tanh_f(float y) { const float t = 0.7978845608028654f * (y + 0.044715f * y * y * y); return y * sigmoid_f(2.0f * t); }
__device__ __forceinline__ int crow(int i, int h) { return (i & 3) + 8 * (i >> 2) + 4 * h; }
#define MFMA32(a, b, c) __builtin_amdgcn_mfma_f32_32x32x16_bf16((a), (b), (c), 0, 0, 0)
__device__ __forceinline__ v4i16_t tr_read(LAS const unsigned char* p) { return __builtin_amdgcn_ds_read_tr16_b64_v4i16((LAS v4i16_t*)p); }
__device__ __forceinline__ void sincos_acc(float ang, float& s_out, float& c_out) {
    double rev = (double)ang * 0.15915494309189535; rev -= __builtin_rint(rev);
    const double x = rev * 6.283185307179586 * 0.125, x2 = x * x;
    double s = x * (1.0 - x2 / 6.0 * (1.0 - x2 / 20.0 * (1.0 - x2 / 42.0 * (1.0 - x2 / 72.0 * (1.0 - x2 / 110.0 * (1.0 - x2 / 156.0))))));
    double c = 1.0 - x2 / 2.0 * (1.0 - x2 / 12.0 * (1.0 - x2 / 30.0 * (1.0 - x2 / 56.0 * (1.0 - x2 / 90.0 * (1.0 - x2 / 132.0 * (1.0 - x2 / 182.0))))));
#pragma unroll
    for (int i = 0; i < 3; ++i) { const double s2 = 2.0 * s * c, c2 = 1.0 - 2.0 * s * s; s = s2; c = c2; }
    s_out = (float)s; c_out = (float)c;
}

struct Params {
    const float *x_prompt, *x_sample, *cache_k, *cache_v, *state_conv, *ssm_re, *ssm_im, *attn_norm, *w_in_ab, *conv_w, *w_out_ab, *ssm_norm, *w_in_c,
        *lam_re, *lam_im, *log_step, *b_re, *b_im, *c_re, *c_im, *d_skip, *w_glu, *b_glu, *w_out_c, *final_norm;
    float* out; unsigned char* ws;
};

__device__ __forceinline__ int w1_dst(int c) {
    if (c < 2048) { const int sec = c >> 10, head = (c & 1023) >> 7, d = c & 127, n = d >> 6, dd = d & 63; const int pn = sec * 4 + (head >> 1), bj = head & 1;
        return pn * 256 + bj * 128 + (dd >> 2) * 8 + n * 4 + (dd & 3); }
    if (c < 4096) return c;
    const int sec = (c >> 10) - 4, ch = c & 1023, qt = ch >> 6;
    return (16 + qt) * 256 + ((ch & 63) << 2) + sec;
}
template <bool MAP> __device__ __forceinline__ void p0_transpose_item(const float* W, int K, int N, bf16* WT, const float* gs, LAS float* scr, int item, int lane) {
    const int nblk = N / 32, kb = item / nblk, nb = item % nblk, k0 = 64 * kb, n0 = 32 * nb;
    float tv[32];
#pragma unroll
    for (int i = 0; i < 32; ++i) { const int kk = 2 * i + (lane >> 5); tv[i] = W[(size_t)(k0 + kk) * N + n0 + (lane & 31)]; }
    if (gs) {
#pragma unroll
        for (int i = 0; i < 32; ++i) tv[i] *= gs[k0 + 2 * i + (lane >> 5)];
    }
#pragma unroll
    for (int i = 0; i < 32; ++i) scr[(2 * i + (lane >> 5)) * 33 + (lane & 31)] = tv[i];
    asm volatile("s_waitcnt lgkmcnt(0)" ::: "memory");
    const int c = lane & 7;
#pragma unroll
    for (int j = 0; j < 4; ++j) { const int n = (lane >> 3) + 8 * j; const LAS float* s = scr + (8 * c) * 33 + n;
        u32x4 o; o.x = cvtpk(s[0 * 33], s[1 * 33]); o.y = cvtpk(s[2 * 33], s[3 * 33]); o.z = cvtpk(s[4 * 33], s[5 * 33]); o.w = cvtpk(s[6 * 33], s[7 * 33]);
        const int row = MAP ? w1_dst(n0 + n) : (n0 + n);
        *(u32x4*)(WT + (size_t)row * K + k0 + 8 * c) = o; }
    asm volatile("s_waitcnt lgkmcnt(0)" ::: "memory");
}

__device__ __forceinline__ void p0_prologue(const Params& P, LAS unsigned char* lds, int gw, int NGW, int lane, int wave) {
    unsigned char* ws = P.ws;
    LAS float* scr = (LAS float*)(lds + wave * 16384);
    constexpr int I1 = 32 * 256, I2 = 32 * 64, I3 = 32 * 128, I4 = 32 * 64, I5 = 32 * 64, NIT = I1 + I2 + I3 + I4 + I5;
    for (int it = gw; it < NIT; it += NGW) {
        int r = it;
        if (r < I1) { p0_transpose_item<true>(P.w_in_ab, 2048, 8192, (bf16*)(ws + WS_W1), P.attn_norm, scr, r, lane); continue; } r -= I1;
        if (r < I2) { p0_transpose_item<false>(P.w_out_ab, 2048, 2048, (bf16*)(ws + WS_W2), nullptr, scr, r, lane); continue; } r -= I2;
        if (r < I3) { p0_transpose_item<false>(P.w_in_c, 2048, 4096, (bf16*)(ws + WS_W3), P.ssm_norm, scr, r, lane); continue; } r -= I3;
        if (r < I4) { p0_transpose_item<false>(P.w_glu, 2048, 2048, (bf16*)(ws + WS_W4), nullptr, scr, r, lane); continue; } r -= I4;
        p0_transpose_item<false>(P.w_out_c, 2048, 2048, (bf16*)(ws + WS_W5), nullptr, scr, r, lane);
    }
    float* rs0 = (float*)(ws + WS_RS0); float* rss1 = (float*)(ws + WS_RSS1); float* rss2 = (float*)(ws + WS_RSS2);
    bf16* X0 = (bf16*)(ws + WS_A);
    for (int row = gw; row < MR; row += NGW) {
        const float* src = row < MP ? P.x_prompt + (size_t)row * DM : P.x_sample + (size_t)(row - MP) * DM;
        const f32x4* s4 = (const f32x4*)src + lane; f32x4 v[8]; float ss = 0.f;
#pragma unroll
        for (int j = 0; j < 8; ++j) { v[j] = s4[64 * j]; ss += (v[j].x * v[j].x + v[j].y * v[j].y) + (v[j].z * v[j].z + v[j].w * v[j].w); }
        ss = wave_sum(ss);
        u32x2* o8 = (u32x2*)(X0 + (size_t)row * DM) + lane;
#pragma unroll
        for (int j = 0; j < 8; ++j) { u32x2 w; w.x = cvtpk(v[j].x, v[j].y); w.y = cvtpk(v[j].z, v[j].w); o8[64 * j] = w; }
        if (lane == 0) { rs0[row] = 1.0f / sqrtf(ss * (1.0f / DM) + RMS_EPS); rss1[row] = 0.f; rss2[row] = 0.f; }
    }
    const int gt = gw * 64 + lane, NGT = NGW * 64;
    float* rope = (float*)(ws + WS_ROPE);
    for (int i = gt; i < 4104 * 64; i += NGT) {
        const int pi = i >> 6, d = i & 63; const int pos = pi < 4096 ? pi : (16384 + pi - 4096);
        double inv = 1.0; for (int k = 0; k < d; ++k) inv *= 0.8659643233600653;
        const float ang = (float)pos * (float)inv; float s, c; sincos_acc(ang, s, c);
        rope[2 * i] = c; rope[2 * i + 1] = s;
    }
    float* ABAR = (float*)(ws + WS_ABAR); float* BBRE = (float*)(ws + WS_BBRE); float* BBIM = (float*)(ws + WS_BBIM);
    bf16* BFRAG = (bf16*)(ws + WS_BFRAG); bf16* CFRAG = (bf16*)(ws + WS_CFRAG);
    for (int it = gt; it < 128 * 64 * 16; it += NGT) {
        const int i = it >> 4, k = it & 15, g = i >> 6, p = i & 63;
        const float lr = P.lam_re[i], li = P.lam_im[i], step = __expf(P.log_step[g]);
        const float mag = __expf(lr * step); float sn, cs; sincos_acc(li * step, sn, cs);
        const float ar = mag * cs, ai = mag * sn;
        if (k == 0) { ABAR[2 * i] = ar; ABAR[2 * i + 1] = ai; }
        const float nr = ar - 1.0f, ni = ai, den = lr * lr + li * li; const float cr = (nr * lr + ni * li) / den, ci = (ni * lr - nr * li) / den;
        const float br = P.b_re[it], bi = P.b_im[it]; const float bbr = cr * br - ci * bi, bbi = cr * bi + ci * br;
        BBRE[it] = bbr; BBIM[it] = bbi;
        const int r = p & 31, blk = p >> 5, ln = r + 32 * (k >> 3), j = k & 7;
        BFRAG[((size_t)(g * 4 + blk) * 64 + ln) * 8 + j] = (bf16)(cvtpk(bbr, 0.f) & 0xffffu);
        BFRAG[((size_t)(g * 4 + 2 + blk) * 64 + ln) * 8 + j] = (bf16)(cvtpk(bbi, 0.f) & 0xffffu);
    }
    for (int it = gt; it < 128 * 8 * 64; it += NGT) {
        const int ln = it & 63, sidx = (it >> 6) & 7, g = it >> 9, ch = ln & 31, h = ln >> 5, comp0 = 16 * sidx + 8 * h;
        float v[8];
#pragma unroll
        for (int e = 0; e < 8; ++e) v[e] = 0.f;
        if (ch < 16) {
            if (comp0 < 64) { const f32x4 a = *(const f32x4*)(P.c_re + ((size_t)g * 16 + ch) * 64 + comp0), b = *(const f32x4*)(P.c_re + ((size_t)g * 16 + ch) * 64 + comp0 + 4);
                v[0] = a[0]; v[1] = a[1]; v[2] = a[2]; v[3] = a[3]; v[4] = b[0]; v[5] = b[1]; v[6] = b[2]; v[7] = b[3]; }
            else { const f32x4 a = *(const f32x4*)(P.c_im + ((size_t)g * 16 + ch) * 64 + comp0 - 64), b = *(const f32x4*)(P.c_im + ((size_t)g * 16 + ch) * 64 + comp0 - 60);
                v[0] = -a[0]; v[1] = -a[1]; v[2] = -a[2]; v[3] = -a[3]; v[4] = -b[0]; v[5] = -b[1]; v[6] = -b[2]; v[7] = -b[3]; }
        }
        *(u32x4*)(CFRAG + (size_t)it * 8) = pack8(v);
    }
}

struct NoCol {};
struct E1 {
    bf16 *Q, *K, *V, *SZA, *CH, *GB; const float* rs0; const float* rope; float* out;
    struct Pre { float rs; f32x4 r0, r1; }; typedef NoCol Col;
    __device__ __forceinline__ Col colpre(int, int) const { return Col{}; }
    __device__ __forceinline__ Pre load(int row, int pn, int pos8) const {
        Pre p; p.rs = rs0[row]; p.r0 = (f32x4){0.f, 0.f, 0.f, 0.f}; p.r1 = p.r0;
        if (pn < 8) { const int posidx = row < MP ? (row & 4095) : (4096 + ((row - MP) & 7)); const int dq = (pos8 & 127) >> 1;
            const f32x4* rp = (const f32x4*)(rope + ((size_t)posidx * 64 + dq) * 2); p.r0 = rp[0]; p.r1 = rp[1]; }
        return p;
    }
    __device__ __forceinline__ float apply(int row, int pn, int pos8, const float (&a)[8], const Pre& pre, const Col&) const {
        const float rs = pre.rs; float v[8];
#pragma unroll
        for (int e = 0; e < 8; ++e) v[e] = a[e] * rs;
        const bool isp = row < MP; const int srow = row - MP;
        if (pn < 8) {
            const int head = 2 * (pn & 3) + (pos8 >> 7), dq = (pos8 & 127) >> 1;
            const f32x4 r0 = pre.r0, r1 = pre.r1;
            const float cs[4] = {r0[0], r0[2], r1[0], r1[2]}, sn[4] = {r0[1], r0[3], r1[1], r1[3]};
            float o1[4], o2[4];
#pragma unroll
            for (int j = 0; j < 4; ++j) { o1[j] = v[j] * cs[j] - v[4 + j] * sn[j]; o2[j] = v[4 + j] * cs[j] + v[j] * sn[j]; }
            const int col = head * 128 + dq;
            if (pn < 4) {
                u32x2 w1, w2; w1.x = cvtpk(o1[0] * C2, o1[1] * C2); w1.y = cvtpk(o1[2] * C2, o1[3] * C2); w2.x = cvtpk(o2[0] * C2, o2[1] * C2); w2.y = cvtpk(o2[2] * C2, o2[3] * C2);
                *(u32x2*)(Q + (size_t)row * 1024 + col) = w1; *(u32x2*)(Q + (size_t)row * 1024 + col + 64) = w2;
            } else {
                u32x2 w1, w2; w1.x = cvtpk(o1[0], o1[1]); w1.y = cvtpk(o1[2], o1[3]); w2.x = cvtpk(o2[0], o2[1]); w2.y = cvtpk(o2[2], o2[3]);
                *(u32x2*)(K + (size_t)row * 1024 + col) = w1; *(u32x2*)(K + (size_t)row * 1024 + col + 64) = w2;
                float* dst = nullptr;
                if (isp) { const int t = row & 4095; if (t >= 2048) dst = out + OUT_KP + ((size_t)(row >> 12) * 2048 + (t - 2048)) * 1024; }
                else dst = out + OUT_KS + (size_t)srow * 1024;
                if (dst) { __builtin_nontemporal_store((f32x4){o1[0], o1[1], o1[2], o1[3]}, (f32x4*)(dst + col)); __builtin_nontemporal_store((f32x4){o2[0], o2[1], o2[2], o2[3]}, (f32x4*)(dst + col + 64)); }
            }
        } else if (pn < 12) {
            const int col = (pn - 8) * 256 + pos8;
            *(u32x4*)(V + (size_t)row * 1024 + col) = pack8(v);
            float* dst = nullptr;
            if (isp) { const int t = row & 4095; if (t >= 2048) dst = out + OUT_VP + ((size_t)(row >> 12) * 2048 + (t - 2048)) * 1024; }
            else dst = out + OUT_VS + (size_t)srow * 1024;
            if (dst) { __builtin_nontemporal_store((f32x4){v[0], v[1], v[2], v[3]}, (f32x4*)(dst + col)); __builtin_nontemporal_store((f32x4){v[4], v[5], v[6], v[7]}, (f32x4*)(dst + col + 4)); }
        } else if (pn < 16) {
            const int col = (pn - 12) * 256 + pos8; float sv[8];
#pragma unroll
            for (int e = 0; e < 8; ++e) sv[e] = silu_f(v[e]);
            *(u32x4*)(SZA + (size_t)row * 1024 + col) = pack8(sv);
        } else {
            const int chn = (pn - 16) * 64 + (pos8 >> 2);
            const float ch0 = v[1] * v[2], ch1 = v[5] * v[6]; const float g0 = v[0] * silu_f(v[3]), g1 = v[4] * silu_f(v[7]);
            *(unsigned*)(CH + (size_t)row * 1024 + chn) = cvtpk(ch0, ch1);
            *(unsigned*)(GB + (size_t)row * 1024 + chn) = cvtpk(g0, g1);
            if (isp) { const int t = row & 4095; if (t >= 4094) { float* d = out + OUT_CP + ((size_t)(row >> 12) * 2 + (t - 4094)) * 1024 + chn; d[0] = ch0; d[1] = ch1; } }
            else { const int sx = srow & 7; if (sx >= 6) { float* d = out + OUT_CS + ((size_t)(srow >> 3) * 2 + (sx - 6)) * 1024 + chn; d[0] = ch0; d[1] = ch1; } }
        }
        return 0.f;
    }
};
struct E2 {
    const float *xp, *xs; bf16* H1b;
    struct Pre { f32x4 x0, x1; }; typedef NoCol Col;
    __device__ __forceinline__ Col colpre(int, int) const { return Col{}; }
    __device__ __forceinline__ Pre load(int row, int pn, int pos8) const {
        const float* xr = (row < MP ? xp + (size_t)row * DM : xs + (size_t)(row - MP) * DM) + pn * 256 + pos8;
        return Pre{*(const f32x4*)xr, *(const f32x4*)(xr + 4)};
    }
    __device__ __forceinline__ float apply(int row, int pn, int pos8, const float (&a)[8], const Pre& pre, const Col&) const {
        const int col = pn * 256 + pos8; const f32x4 x0 = pre.x0, x1 = pre.x1;
        float h[8] = {x0[0] + a[0], x0[1] + a[1], x0[2] + a[2], x0[3] + a[3], x1[0] + a[4], x1[1] + a[5], x1[2] + a[6], x1[3] + a[7]};
        *(u32x4*)(H1b + (size_t)row * DM + col) = pack8(h);
        float ss = 0.f;
#pragma unroll
        for (int e = 0; e < 8; ++e) ss += h[e] * h[e];
        return ss;
    }
};
struct E3 {
    const float* rss1; bf16 *U, *ZS;
    struct Pre { float rss; }; typedef NoCol Col;
    __device__ __forceinline__ Col colpre(int, int) const { return Col{}; }
    __device__ __forceinline__ Pre load(int row, int, int) const { return Pre{rss1[row]}; }
    __device__ __forceinline__ float apply(int row, int pn, int pos8, const float (&a)[8], const Pre& pre, const Col&) const {
        const float rs = 1.0f / sqrtf(pre.rss * (1.0f / DM) + RMS_EPS); float v[8];
        if (pn < 8) {
#pragma unroll
            for (int e = 0; e < 8; ++e) v[e] = a[e] * rs;
            *(u32x4*)(U + (size_t)row * DM + pn * 256 + pos8) = pack8(v);
        } else {
#pragma unroll
            for (int e = 0; e < 8; ++e) v[e] = silu_f(a[e] * rs);
            *(u32x4*)(ZS + (size_t)row * DM + (pn - 8) * 256 + pos8) = pack8(v);
        }
        return 0.f;
    }
};
struct E4 {
    const bf16 *YG, *ZS; const float* bglu; bf16* ACT2;
    struct Pre { u32x4 y, z; }; struct Col { f32x4 b0, b1; };
    __device__ __forceinline__ Col colpre(int pn, int pos8) const { const int col = pn * 256 + pos8; return Col{*(const f32x4*)(bglu + col), *(const f32x4*)(bglu + col + 4)}; }
    __device__ __forceinline__ Pre load(int row, int pn, int pos8) const { const size_t off = (size_t)row * DM + pn * 256 + pos8; return Pre{*(const u32x4*)(YG + off), *(const u32x4*)(ZS + off)}; }
    __device__ __forceinline__ float apply(int row, int pn, int pos8, const float (&a)[8], const Pre& pre, const Col& cp) const {
        const size_t off = (size_t)row * DM + pn * 256 + pos8;
        float y[8], z[8], o[8]; unpack8(pre.y, y); unpack8(pre.z, z);
        const float bb[8] = {cp.b0[0], cp.b0[1], cp.b0[2], cp.b0[3], cp.b1[0], cp.b1[1], cp.b1[2], cp.b1[3]};
#pragma unroll
        for (int e = 0; e < 8; ++e) o[e] = y[e] * sigmoid_f(a[e] + bb[e]) * z[e];
        *(u32x4*)(ACT2 + off) = pack8(o);
        return 0.f;
    }
};
struct E5 {
    const bf16* H1b; float* out;
    struct Pre { u32x4 h; }; typedef NoCol Col;
    __device__ __forceinline__ Col colpre(int, int) const { return Col{}; }
    __device__ __forceinline__ Pre load(int row, int pn, int pos8) const { return Pre{*(const u32x4*)(H1b + (size_t)row * DM + pn * 256 + pos8)}; }
    __device__ __forceinline__ float apply(int row, int pn, int pos8, const float (&a)[8], const Pre& pre, const Col&) const {
        float* o = out + (size_t)row * DM + pn * 256 + pos8; float x[8]; unpack8(pre.h, x);
        const float h[8] = {x[0] + a[0], x[1] + a[1], x[2] + a[2], x[3] + a[3], x[4] + a[4], x[5] + a[5], x[6] + a[6], x[7] + a[7]};
        *(f32x4*)o = (f32x4){h[0], h[1], h[2], h[3]}; *(f32x4*)(o + 4) = (f32x4){h[4], h[5], h[6], h[7]};
        float ss = 0.f;
#pragma unroll
        for (int e = 0; e < 8; ++e) ss += h[e] * h[e];
        return ss;
    }
};
struct E5F {
    static constexpr bool PERM = true, AFTER_DRAIN = true;
    const bf16* H1b; float* out; float* rss2; unsigned* cnt; const float* fnorm;
    __device__ __forceinline__ void fused(f32x4 (&acc)[2][2][4][2], const pg8::Unit& u, int wr, int wc, int fr, int fq, LAS unsigned char*, int, int) const {
#pragma unroll
        for (int am = 0; am < 4; ++am) {
            const int ai = am >> 1, m0 = (am & 1) * 2; u32x4 pre[2][2];
#pragma unroll
            for (int mm = 0; mm < 2; ++mm)
#pragma unroll
                for (int bj = 0; bj < 2; ++bj) pre[mm][bj] = *(const u32x4*)(H1b + (size_t)(u.pm * 256 + ai * 128 + wr * 64 + (m0 + mm) * 16 + fr) * DM + u.pn * 256 + bj * 128 + wc * 32 + 8 * fq);
#pragma unroll
            for (int mm = 0; mm < 2; ++mm) {
                const int m = m0 + mm, row = u.pm * 256 + ai * 128 + wr * 64 + m * 16 + fr; float ss = 0.f;
#pragma unroll
                for (int bj = 0; bj < 2; ++bj) { float x[8]; unpack8(pre[mm][bj], x);
                    acc[ai][bj][m][0] += (f32x4){x[0], x[1], x[2], x[3]}; acc[ai][bj][m][1] += (f32x4){x[4], x[5], x[6], x[7]};
                    const f32x4 c0 = acc[ai][bj][m][0], c1 = acc[ai][bj][m][1];
                    ss += (c0[0] * c0[0] + c0[1] * c0[1]) + (c0[2] * c0[2] + c0[3] * c0[3]) + (c1[0] * c1[0] + c1[1] * c1[1]) + (c1[2] * c1[2] + c1[3] * c1[3]); }
                ss += __shfl_xor(ss, 16); ss += __shfl_xor(ss, 32); if (fq == 0) unsafeAtomicAdd(rss2 + row, ss);
            }
        }
        asm volatile("s_waitcnt vmcnt(0)" ::: "memory");
        __syncthreads();
        if (threadIdx.x == 0) {
            unsigned* c = cnt + 64 * u.pm;
            __hip_atomic_fetch_add(c, 1u, __ATOMIC_RELAXED, __HIP_MEMORY_SCOPE_AGENT);
            unsigned sp = 0;
            while (__hip_atomic_load(c, __ATOMIC_RELAXED, __HIP_MEMORY_SCOPE_AGENT) < 8u) { __builtin_amdgcn_s_sleep(1); if (++sp > (1u << 22)) break; }
            __builtin_amdgcn_fence(__ATOMIC_ACQUIRE, "agent");
            asm volatile("s_waitcnt vmcnt(0)" ::: "memory");
        }
        __syncthreads();
        f32x4 gn[2][2];
#pragma unroll
        for (int bj = 0; bj < 2; ++bj) { const float* gp = fnorm + u.pn * 256 + bj * 128 + wc * 32 + 8 * fq; gn[bj][0] = *(const f32x4*)gp; gn[bj][1] = *(const f32x4*)(gp + 4); }
#pragma unroll
        for (int ai = 0; ai < 2; ++ai)
#pragma unroll
            for (int m = 0; m < 4; ++m) {
                const int row = u.pm * 256 + ai * 128 + wr * 64 + m * 16 + fr;
                const float rs = 1.0f / sqrtf(__hip_atomic_load(rss2 + row, __ATOMIC_RELAXED, __HIP_MEMORY_SCOPE_AGENT) * (1.0f / DM) + RMS_EPS);
#pragma unroll
                for (int bj = 0; bj < 2; ++bj) { float* o = out + (size_t)row * DM + u.pn * 256 + bj * 128 + wc * 32 + 8 * fq;
                    __builtin_nontemporal_store(acc[ai][bj][m][0] * rs * gn[bj][0], (f32x4*)o); __builtin_nontemporal_store(acc[ai][bj][m][1] * rs * gn[bj][1], (f32x4*)(o + 4)); }
            }
    }
};
template <class EF, bool RSS> struct EpiWrap {
    static constexpr bool PERM = true, AFTER_DRAIN = false;
    EF ef; float* rss;
    __device__ __forceinline__ void operator()(const f32x4 (&acc)[2][2][4][2], const pg8::Unit& u, int wr, int wc, int fr, int fq) const {
        typename EF::Col cp[2];
#pragma unroll
        for (int bj = 0; bj < 2; ++bj) cp[bj] = ef.colpre(u.pn, bj * 128 + wc * 32 + 8 * fq);
#pragma unroll
        for (int am = 0; am < 4; ++am) {
            const int ai = am >> 1, m0 = (am & 1) * 2;
            typename EF::Pre pre[2][2];
#pragma unroll
            for (int mm = 0; mm < 2; ++mm)
#pragma unroll
                for (int bj = 0; bj < 2; ++bj) pre[mm][bj] = ef.load(u.pm * 256 + ai * 128 + wr * 64 + (m0 + mm) * 16 + fr, u.pn, bj * 128 + wc * 32 + 8 * fq);
            asm volatile("" ::: "memory");
#pragma unroll
            for (int mm = 0; mm < 2; ++mm) {
                const int m = m0 + mm;
                const int row = u.pm * 256 + ai * 128 + wr * 64 + m * 16 + fr; float ss = 0.f;
#pragma unroll
                for (int bj = 0; bj < 2; ++bj) {
                    const f32x4 c0 = acc[ai][bj][m][0], c1 = acc[ai][bj][m][1];
                    const float a[8] = {c0[0], c0[1], c0[2], c0[3], c1[0], c1[1], c1[2], c1[3]};
                    ss += ef.apply(row, u.pn, bj * 128 + wc * 32 + 8 * fq, a, pre[mm][bj], cp[bj]);
                }
                if (RSS) { ss += __shfl_xor(ss, 16); ss += __shfl_xor(ss, 32); if (fq == 0) unsafeAtomicAdd(rss + row, ss); }
            }
            asm volatile("" ::: "memory");
        }
    }
};
template <class EF, bool RSS> __device__ __forceinline__ void skinny_gemm(LAS unsigned char* lds, const bf16* A, const bf16* Bt, int N, const EF& ef, float* rss, int vcu, int G) {
    constexpr int K = 2048;
    int tid_ = threadIdx.x; asm volatile("" : "+v"(tid_)); const int tid = tid_, lane = tid & 63, wid = __builtin_amdgcn_readfirstlane(tid >> 6), r = lane & 31, h = lane >> 5;
    LAS float* red = (LAS float*)lds;
    const int nsl = N / 32;
    for (int sl = vcu; sl < nsl; sl += G) {
        const int n0 = sl * 32, kw = wid & 3, rt = wid >> 2;
        const bf16* ap = A + (size_t)(rt * 32 + r) * K + kw * 512 + 8 * h;
        const bf16* bp = Bt + (size_t)(n0 + r) * K + kw * 512 + 8 * h;
        f32x16 acc;
#pragma unroll
        for (int i = 0; i < 16; ++i) acc[i] = 0.f;
#pragma unroll 1
        for (int s0 = 0; s0 < 32; s0 += 16) {
            bf16x8 af[16], bfv[16];
#pragma unroll
            for (int s = 0; s < 16; ++s) { af[s] = *(const bf16x8*)(ap + 16 * (s0 + s)); bfv[s] = *(const bf16x8*)(bp + 16 * (s0 + s)); }
#pragma unroll
            for (int s = 0; s < 16; ++s) acc = MFMA32(af[s], bfv[s], acc);
        }
#pragma unroll
        for (int i = 0; i < 16; ++i) red[(wid * 32 + crow(i, h)) * 33 + r] = acc[i];
        __syncthreads();
        if (tid < 256) {
            const int row = tid >> 2, cgp = tid & 3, rt2 = row >> 5, rr = row & 31; float v[8];
#pragma unroll
            for (int e = 0; e < 8; ++e) { float s = 0.f;
#pragma unroll
                for (int k = 0; k < 4; ++k) s += red[((rt2 * 4 + k) * 32 + rr) * 33 + 8 * cgp + e];
                v[e] = s; }
            const typename EF::Col cpre = ef.colpre(n0 >> 8, (n0 & 255) + 8 * cgp);
            const typename EF::Pre pre = ef.load(MP + row, n0 >> 8, (n0 & 255) + 8 * cgp);
            float ss = ef.apply(MP + row, n0 >> 8, (n0 & 255) + 8 * cgp, v, pre, cpre);
            if (RSS) { ss += __shfl_xor(ss, 1); ss += __shfl_xor(ss, 2); if (cgp == 0) unsafeAtomicAdd(rss + MP + row, ss); }
        }
        __syncthreads();
    }
}
template <class EF, bool RSS> __device__ __forceinline__ void gemm_all(LAS unsigned char* lds, const bf16* A, const bf16* Bt, int N, const EF& ef, float* rss, int vcu, int G) {
    skinny_gemm<EF, RSS>(lds, A + (size_t)MP * 2048, Bt, N, ef, rss, vcu, G);
    pg8::Gemm g{A, Bt, MP, N, 2048}; pg8::StaticOrder S; S.init(MP, N, G, (int)blockIdx.x);
    EpiWrap<EF, RSS> E{ef, rss};
    pg8::gemm_phase<EpiWrap<EF, RSS>, pg8::StaticOrder, true, true>(lds, g, S, E);
}

__device__ __forceinline__ void gemm5_fused(LAS unsigned char* lds, const bf16* A, const bf16* Bt, const bf16* H1b, float* out, float* rss2, unsigned* cnt, const float* fnorm, int vcu, int G) {
    E5 es{H1b, out};
    skinny_gemm<E5, true>(lds, A + (size_t)MP * 2048, Bt, 2048, es, rss2, vcu, G);
    asm volatile("s_waitcnt vmcnt(0)" ::: "memory");
    __syncthreads();
    if (vcu < 64 && threadIdx.x == 0) __hip_atomic_fetch_add(cnt + 64 * 40, 1u, __ATOMIC_RELAXED, __HIP_MEMORY_SCOPE_AGENT);
    pg8::Gemm g{A, Bt, MP, 2048, 2048}; pg8::StaticOrder S; S.init(MP, 2048, G, (int)blockIdx.x);
    E5F E{H1b, out, rss2, cnt, fnorm};
    pg8::gemm_phase<E5F, pg8::StaticOrder, false, true>(lds, g, S, E);
    if (vcu < 64) {
        if (threadIdx.x == 0) { unsigned sp = 0; while (__hip_atomic_load(cnt + 64 * 40, __ATOMIC_RELAXED, __HIP_MEMORY_SCOPE_AGENT) < 64u) { __builtin_amdgcn_s_sleep(1); if (++sp > (1u << 22)) break; }
            __builtin_amdgcn_fence(__ATOMIC_ACQUIRE, "agent"); asm volatile("s_waitcnt vmcnt(0)" ::: "memory"); }
        __syncthreads();
        const int tid = threadIdx.x;
        if (tid < 256) { const int row = MP + (tid >> 2), col = vcu * 32 + 8 * (tid & 3);
            const float rs = 1.0f / sqrtf(__hip_atomic_load(rss2 + row, __ATOMIC_RELAXED, __HIP_MEMORY_SCOPE_AGENT) * (1.0f / DM) + RMS_EPS);
            float* o = out + (size_t)row * DM + col; const f32x4 g0 = *(const f32x4*)(fnorm + col), g1 = *(const f32x4*)(fnorm + col + 4);
            const f32x4 v0 = *(const f32x4*)o, v1 = *(const f32x4*)(o + 4);
            *(f32x4*)o = v0 * rs * g0; *(f32x4*)(o + 4) = v1 * rs * g1; }
    }
}

__device__ __forceinline__ void attn_prompt_phase(LAS unsigned char* lds, const bf16* Q, const bf16* K, const bf16* V, bf16* OG, float* L2G, int vcu, int G, int gsel = -1) {
    int tid_ = threadIdx.x; asm volatile("" : "+v"(tid_)); const int tid = tid_, lane = tid & 63, wid = __builtin_amdgcn_readfirstlane(tid >> 6), r = lane & 31, hh = lane >> 5;
    constexpr int VSTR = 272;
    const int i16 = lane & 15, tq = i16 >> 2, tp = i16 & 3, tblk = (lane >> 4) & 1;
    const int xq_ = vcu >> 5, xr_ = vcu & 31;
    for (int ui = 0; G > 0 ? (vcu + ui * G < 768) : (ui * (-G) + xr_ < 96); ++ui) {
        const int unit = G > 0 ? vcu + ui * G : 2 * xq_ * 48 + ui * (-G) + xr_;
        const int x = unit & 15; int t1 = unit >> 4; const int g = t1 % 3; t1 /= 3; const int h = t1 & 7, b = t1 >> 3;
        const int lg = 2 * g, dil = 1 << lg, cls = x & (dil - 1), ub = x >> lg;
        const int kbase = 256 * ub - 128;
        const size_t rb = (size_t)b * TP;
        u32x4 vst[12];
        {
            u32x4 kst[12];
#pragma unroll
            for (int i = 0; i < 12; ++i) { const int piece = tid + 512 * i, kl = piece >> 4, part = piece & 15, ki = kbase + kl; kst[i] = (u32x4){0u, 0u, 0u, 0u};
                if (ki >= 0) kst[i] = *(const u32x4*)(K + (rb + (size_t)ki * dil + cls) * 1024 + h * 128 + part * 8); }
#pragma unroll
            for (int i = 0; i < 12; ++i) { const int piece = tid + 512 * i, kl = piece >> 4, part = piece & 15, ki = kbase + kl; vst[i] = (u32x4){0u, 0u, 0u, 0u};
                if (ki >= 0) vst[i] = *(const u32x4*)(V + (rb + (size_t)ki * dil + cls) * 1024 + h * 128 + part * 8); }
#pragma unroll
            for (int i = 0; i < 12; ++i) { const int piece = tid + 512 * i, kl = piece >> 4, part = piece & 15; *(LAS u32x4*)(lds + kl * VSTR + part * 16) = kst[i]; }
        }
        const int q0 = 256 * ub + 32 * wid; const size_t qrow = rb + (size_t)(q0 + r) * dil + cls;
        bf16x8 qf[8];
#pragma unroll
        for (int s = 0; s < 8; ++s) qf[s] = *(const bf16x8*)(Q + qrow * 1024 + h * 128 + 16 * s + 8 * hh);
        __syncthreads();
        f32x16 p[5];
#pragma unroll
        for (int c = 0; c < 5; ++c) {
            const int kb = q0 - 128 + 32 * c;
            if (kb < 0) {
#pragma unroll
                for (int i = 0; i < 16; ++i) p[c][i] = -INFINITY;
            } else {
                LAS const unsigned char* kp = lds + (32 * wid + 32 * c + r) * VSTR + 16 * hh;
                f32x16 acc;
#pragma unroll
                for (int i = 0; i < 16; ++i) acc[i] = 0.f;
#pragma unroll
                for (int s = 0; s < 8; ++s) { const bf16x8 kf = *(LAS const bf16x8*)(kp + 32 * s); acc = MFMA32(kf, qf[s], acc); }
                p[c] = acc;
            }
        }
#pragma unroll
        for (int i = 0; i < 16; ++i) { const int cr = crow(i, hh); if (r > cr) p[0][i] = -INFINITY; if (cr > r) p[4][i] = -INFINITY; }
        float m = -INFINITY;
#pragma unroll
        for (int c = 0; c < 5; ++c)
#pragma unroll
            for (int i = 0; i < 16; ++i) m = fmaxf(m, p[c][i]);
        m = fmaxf(m, __shfl_xor(m, 32));
        float l = 0.f;
#pragma unroll
        for (int c = 0; c < 5; ++c)
#pragma unroll
            for (int i = 0; i < 16; ++i) { const float e = __builtin_amdgcn_exp2f(p[c][i] - m); p[c][i] = e; l += e; }
        l += __shfl_xor(l, 32);
        __syncthreads();
#pragma unroll
        for (int i = 0; i < 12; ++i) { const int piece = tid + 512 * i, kl = piece >> 4, part = piece & 15; *(LAS u32x4*)(lds + kl * VSTR + part * 16) = vst[i]; }
        __syncthreads();
        f32x16 o[4];
#pragma unroll
        for (int d = 0; d < 4; ++d)
#pragma unroll
            for (int i = 0; i < 16; ++i) o[d][i] = 0.f;
#pragma unroll
        for (int c = 0; c < 5; ++c) {
            const int kb = q0 - 128 + 32 * c;
            if (kb >= 0) {
#pragma unroll
                for (int s2 = 0; s2 < 2; ++s2) {
                    u32x4 pw; pw.x = cvtpk(p[c][8 * s2 + 0], p[c][8 * s2 + 1]); pw.y = cvtpk(p[c][8 * s2 + 2], p[c][8 * s2 + 3]); pw.z = cvtpk(p[c][8 * s2 + 4], p[c][8 * s2 + 5]); pw.w = cvtpk(p[c][8 * s2 + 6], p[c][8 * s2 + 7]);
                    const bf16x8 pb = __builtin_bit_cast(bf16x8, pw);
                    LAS const unsigned char* vb = lds + (32 * wid + 32 * c + 16 * s2 + 4 * hh + tq) * VSTR + (16 * tblk + 4 * tp) * 2;
#pragma unroll
                    for (int d = 0; d < 4; ++d) {
                        const v4i16_t lo = tr_read(vb + d * 64), hi = tr_read(vb + 8 * VSTR + d * 64);
                        const bf16x8 va = __builtin_shufflevector(lo, hi, 0, 1, 2, 3, 4, 5, 6, 7);
                        o[d] = MFMA32(va, pb, o[d]);
                    }
                }
            }
        }
        const float inv = 1.0f / l;
        bf16* orow = OG + ((size_t)g * MR + qrow) * 1024 + h * 128;
#pragma unroll
        for (int d = 0; d < 4; ++d)
#pragma unroll
            for (int gi = 0; gi < 4; ++gi) { u32x2 w; w.x = cvtpk(o[d][4 * gi] * inv, o[d][4 * gi + 1] * inv); w.y = cvtpk(o[d][4 * gi + 2] * inv, o[d][4 * gi + 3] * inv);
                *(u32x2*)(orow + 32 * d + 8 * gi + 4 * hh) = w; }
        if (hh == 0) L2G[((size_t)g * MR + qrow) * 8 + h] = m + __builtin_amdgcn_logf(l);
        __syncthreads();
    }
}

__device__ __forceinline__ f32x2 smp_row(const float* cache, const bf16* nb, int b, int s, int h, int dil, int j, int lane) {
    const int idx = 2048 + s - dil * j;
    if (idx >= 2048) { const unsigned w = *(const unsigned*)(nb + (size_t)(MP + b * 8 + (idx - 2048)) * 1024 + h * 128 + 2 * lane); return (f32x2){__uint_as_float(w << 16), __uint_as_float(w & 0xffff0000u)}; }
    return *(const f32x2*)(cache + (((size_t)b * 2048 + idx) * 8 + h) * 128 + 2 * lane);
}
__device__ __forceinline__ const float* smp_base(const float* cache, int b, int s, int h, int lane) {
    const float* p = cache + (((size_t)b * 2048 + 2048 + s) * 8 + h) * 128 + 2 * lane; asm volatile("" : "+v"(p)); return p;
}
__device__ __forceinline__ f32x2 smp_row_cache(const float* base, int dil, int j) { return *(const f32x2*)(base - (size_t)j * dil * 1024); }
__device__ __forceinline__ float reduce16(float (&v)[16], int lane) {
#pragma unroll
    for (int i = 0; i < 8; ++i) { const bool up = lane & 1; const float send = up ? v[i] : v[i + 8], keep = up ? v[i + 8] : v[i]; v[i] = keep + __shfl_xor(send, 1); }
#pragma unroll
    for (int i = 0; i < 4; ++i) { const bool up = lane & 2; const float send = up ? v[i] : v[i + 4], keep = up ? v[i + 4] : v[i]; v[i] = keep + __shfl_xor(send, 2); }
#pragma unroll
    for (int i = 0; i < 2; ++i) { const bool up = lane & 4; const float send = up ? v[i] : v[i + 2], keep = up ? v[i + 2] : v[i]; v[i] = keep + __shfl_xor(send, 4); }
    { const bool up = lane & 8; const float send = up ? v[0] : v[1], keep = up ? v[1] : v[0]; v[0] = keep + __shfl_xor(send, 8); }
    float t = v[0]; t += __shfl_xor(t, 16); t += __shfl_xor(t, 32); return t;
}
template <bool FIRST> __device__ __forceinline__ void smp_batch32(LAS float* sm, const Params& P, const bf16* K, const bf16* V, const float* kbase, const float* vbase, int b, int s, int h, int dil, int j0,
                                                                  f32x2 q2, int lane, int br4, float& M, float& lsum, float& a0, float& a1) {
    f32x2 kr[32], vr[32];
#pragma unroll
    for (int i = 0; i < 32; ++i) kr[i] = (FIRST && i < 8) ? smp_row(P.cache_k, K, b, s, h, dil, i, lane) : smp_row_cache(kbase, dil, j0 + i);
#pragma unroll
    for (int i = 0; i < 32; ++i) vr[i] = (FIRST && i < 8) ? smp_row(P.cache_v, V, b, s, h, dil, i, lane) : smp_row_cache(vbase, dil, j0 + i);
    float v[16], w[16];
#pragma unroll
    for (int i = 0; i < 16; ++i) { v[i] = q2[0] * kr[i][0] + q2[1] * kr[i][1]; w[i] = q2[0] * kr[16 + i][0] + q2[1] * kr[16 + i][1]; }
    const float t0 = reduce16(v, lane), t1 = reduce16(w, lane);
    float mb = fmaxf(t0, t1);
#pragma unroll
    for (int o = 1; o < 16; o <<= 1) mb = fmaxf(mb, __shfl_xor(mb, o));
    const float Mn = fmaxf(M, mb), sc = __builtin_amdgcn_exp2f(M - Mn); a0 *= sc; a1 *= sc; lsum *= sc; M = Mn;
    if (lane < 16) { sm[br4] = __builtin_amdgcn_exp2f(t0 - Mn); sm[16 + br4] = __builtin_amdgcn_exp2f(t1 - Mn); }
    asm volatile("s_waitcnt lgkmcnt(0)" ::: "memory");
#pragma unroll
    for (int i = 0; i < 32; ++i) { const float pj = sm[i]; lsum += pj; a0 += pj * vr[i][0]; a1 += pj * vr[i][1]; }
    asm volatile("s_waitcnt lgkmcnt(0)" ::: "memory");
}
__device__ __forceinline__ void attn_sample_item(LAS float* sm, int item, const Params& P, const bf16* Q, const bf16* K, const bf16* V, bf16* OG, float* L2G, int lane) {
    const int g = item % 3, t1 = item / 3, h = t1 & 7, bs = t1 >> 3, b = bs >> 3, s = bs & 7; const size_t row = MP + bs;
    const int dil = 1 << (2 * g);
    f32x2 q2; { const unsigned qv = *(const unsigned*)(Q + row * 1024 + h * 128 + 2 * lane); q2 = (f32x2){__uint_as_float(qv << 16), __uint_as_float(qv & 0xffff0000u)}; }
    const float* kbase = smp_base(P.cache_k, b, s, h, lane); const float* vbase = smp_base(P.cache_v, b, s, h, lane);
    const int br4 = ((lane & 1) << 3) | ((lane & 2) << 1) | ((lane & 4) >> 1) | ((lane & 8) >> 3);
    float M = -INFINITY, lsum = 0.f, a0 = 0.f, a1 = 0.f;
    smp_batch32<true>(sm, P, K, V, kbase, vbase, b, s, h, dil, 0, q2, lane, br4, M, lsum, a0, a1);
#pragma unroll 1
    for (int jb = 32; jb < 128; jb += 32) smp_batch32<false>(sm, P, K, V, kbase, vbase, b, s, h, dil, jb, q2, lane, br4, M, lsum, a0, a1);
    {
        const f32x2 kr = smp_row_cache(kbase, dil, 128), vr = smp_row_cache(vbase, dil, 128);
        const float t = wave_sum(q2[0] * kr[0] + q2[1] * kr[1]);
        const float Mn = fmaxf(M, t), sc = __builtin_amdgcn_exp2f(M - Mn), pj = __builtin_amdgcn_exp2f(t - Mn);
        a0 = a0 * sc + pj * vr[0]; a1 = a1 * sc + pj * vr[1]; lsum = lsum * sc + pj; M = Mn;
    }
    const float il = 1.0f / lsum;
    *(unsigned*)(OG + ((size_t)g * MR + row) * 1024 + h * 128 + 2 * lane) = cvtpk(a0 * il, a1 * il);
    if (lane == 0) L2G[((size_t)g * MR + row) * 8 + h] = M + __builtin_amdgcn_logf(lsum);
}

__device__ __forceinline__ void merge_conv_phase(const Params& P, const bf16* __restrict__ OG, const float* __restrict__ L2G, const bf16* __restrict__ SZA, const bf16* __restrict__ CH,
                                                 const bf16* __restrict__ GB, bf16* __restrict__ ACT1, int gtid, int ngt) {
    constexpr int NI = MR * 128, UB = 2;
    for (int base = gtid; base < NI; base += UB * ngt) {
        u32x4 ra[UB], rb[UB], rc[UB], rz[UB]; float L0[UB], L1[UB], L2[UB];
#pragma unroll
        for (int u = 0; u < UB; ++u) { const int idx = base + u * ngt; if (idx < NI) { const int row = idx >> 7, cgp = idx & 127, h = cgp >> 4;
            L0[u] = L2G[((size_t)0 * MR + row) * 8 + h]; L1[u] = L2G[((size_t)1 * MR + row) * 8 + h]; L2[u] = L2G[((size_t)2 * MR + row) * 8 + h];
            ra[u] = *(const u32x4*)(OG + ((size_t)0 * MR + row) * 1024 + cgp * 8); rb[u] = *(const u32x4*)(OG + ((size_t)1 * MR + row) * 1024 + cgp * 8);
            rc[u] = *(const u32x4*)(OG + ((size_t)2 * MR + row) * 1024 + cgp * 8); rz[u] = *(const u32x4*)(SZA + (size_t)row * 1024 + cgp * 8); } }
#pragma unroll
        for (int u = 0; u < UB; ++u) { const int idx = base + u * ngt; if (idx < NI) { const int row = idx >> 7, cgp = idx & 127;
            const float M = fmaxf(fmaxf(L0[u], L1[u]), L2[u]); float w0 = __builtin_amdgcn_exp2f(L0[u] - M), w1 = __builtin_amdgcn_exp2f(L1[u] - M), w2 = __builtin_amdgcn_exp2f(L2[u] - M);
            const float iw = 1.0f / (w0 + w1 + w2); w0 *= iw; w1 *= iw; w2 *= iw;
            float a[8], bb[8], c[8], z[8], o[8]; unpack8(ra[u], a); unpack8(rb[u], bb); unpack8(rc[u], c); unpack8(rz[u], z);
#pragma unroll
            for (int e = 0; e < 8; ++e) o[e] = (w0 * a[e] + w1 * bb[e] + w2 * c[e]) * z[e];
            *(u32x4*)(ACT1 + (size_t)row * 2048 + cgp * 8) = pack8(o); } }
    }
    for (int base = gtid; base < NI; base += UB * ngt) {
        u32x4 r0[UB], r1[UB], r2[UB], rg[UB];
#pragma unroll
        for (int u = 0; u < UB; ++u) { const int idx = base + u * ngt; if (idx < NI) { const int row = idx >> 7, c0 = (idx & 127) * 8;
            const int t = row < MP ? (row & 4095) : ((row - MP) & 7);
            r2[u] = *(const u32x4*)(CH + (size_t)row * 1024 + c0); rg[u] = *(const u32x4*)(GB + (size_t)row * 1024 + c0);
            r1[u] = (u32x4){0u, 0u, 0u, 0u}; r0[u] = r1[u];
            if (t >= 1) r1[u] = *(const u32x4*)(CH + (size_t)(row - 1) * 1024 + c0);
            if (t >= 2) r0[u] = *(const u32x4*)(CH + (size_t)(row - 2) * 1024 + c0); } }
#pragma unroll
        for (int u = 0; u < UB; ++u) { const int idx = base + u * ngt; if (idx < NI) { const int row = idx >> 7, c0 = (idx & 127) * 8;
            float u0[8], u1[8], u2[8], gb[8], o[8]; unpack8(r0[u], u0); unpack8(r1[u], u1); unpack8(r2[u], u2); unpack8(rg[u], gb);
            if (row >= MP) { const int t = (row - MP) & 7, bsm = (row - MP) >> 3;
                if (t < 1) {
#pragma unroll
                    for (int e = 0; e < 8; ++e) u1[e] = P.state_conv[((size_t)bsm * 2 + 1) * 1024 + c0 + e];
                }
                if (t < 2) {
#pragma unroll
                    for (int e = 0; e < 8; ++e) u0[e] = P.state_conv[((size_t)bsm * 2 + t) * 1024 + c0 + e];
                }
            }
#pragma unroll
            for (int e = 0; e < 8; ++e) o[e] = gb[e] * (P.conv_w[c0 + e] * u0[e] + P.conv_w[1024 + c0 + e] * u1[e] + P.conv_w[2048 + c0 + e] * u2[e]);
            *(u32x4*)(ACT1 + (size_t)row * 2048 + 1024 + c0) = pack8(o); } }
    }
}
struct Cx { float r, i; };
__device__ __forceinline__ Cx cmul(Cx a, Cx b) { return Cx{a.r * b.r - a.i * b.i, a.r * b.i + a.i * b.r}; }
__device__ __forceinline__ Cx cfma(Cx a, Cx x, Cx y) { return Cx{a.r * x.r - a.i * x.i + y.r, a.r * x.i + a.i * x.r + y.i}; }
__device__ __forceinline__ Cx csel(bool c, Cx a, Cx b) { return Cx{c ? a.r : b.r, c ? a.i : b.i}; }
__device__ __forceinline__ Cx cshfl32(Cx a) { return Cx{__shfl_xor(a.r, 32), __shfl_xor(a.i, 32)}; }

template <bool APPLY> __device__ __forceinline__ void scan_subblock(f32x16& re, f32x16& im, Cx& H, const Cx A1, const Cx A2, const Cx A3, const Cx A4, const bool hi_half) {
    Cx E[4];
#pragma unroll
    for (int gi = 0; gi < 4; ++gi) {
        Cx x{re[4 * gi], im[4 * gi]};
#pragma unroll
        for (int j = 1; j < 4; ++j) { x = cfma(A1, x, Cx{re[4 * gi + j], im[4 * gi + j]}); re[4 * gi + j] = x.r; im[4 * gi + j] = x.i; }
        E[gi] = x;
    }
    Cx cin_own[4]; Cx cin = H;
#pragma unroll
    for (int gi = 0; gi < 4; ++gi) {
        const Cx Eo = cshfl32(E[gi]);
        const Cx e_even = csel(hi_half, Eo, E[gi]), e_odd = csel(hi_half, E[gi], Eo);
        const Cx cin_even = cin; cin = cfma(A4, cin, e_even);
        const Cx cin_odd = cin; cin = cfma(A4, cin, e_odd);
        cin_own[gi] = csel(hi_half, cin_odd, cin_even);
    }
    H = cin;
    if (APPLY) {
#pragma unroll
        for (int gi = 0; gi < 4; ++gi) {
            Cx t;
            t = cmul(A1, cin_own[gi]); re[4 * gi + 0] += t.r; im[4 * gi + 0] += t.i;
            t = cmul(A2, cin_own[gi]); re[4 * gi + 1] += t.r; im[4 * gi + 1] += t.i;
            t = cmul(A3, cin_own[gi]); re[4 * gi + 2] += t.r; im[4 * gi + 2] += t.i;
            t = cmul(A4, cin_own[gi]); re[4 * gi + 3] += t.r; im[4 * gi + 3] += t.i;
        }
    }
}
__device__ __forceinline__ void store_img(LAS unsigned char* img, const f32x16& x, int comp, int hh) {
#pragma unroll
    for (int gi = 0; gi < 4; ++gi) { u32x2 w; w.x = cvtpk(x[4 * gi], x[4 * gi + 1]); w.y = cvtpk(x[4 * gi + 2], x[4 * gi + 3]); *(LAS u32x2*)(img + comp * 64 + 8 * (2 * gi + hh)) = w; }
}

template <int PASS> __device__ __forceinline__ void ssm_prompt_phase(LAS unsigned char* lds, const Params& P, const bf16* __restrict__ U, bf16* __restrict__ YG, const float* __restrict__ SBUF, int vcu, int G) {
    int tid_ = threadIdx.x; asm volatile("" : "+v"(tid_)); const int tid = tid_, lane = tid & 63, wid = __builtin_amdgcn_readfirstlane(tid >> 6), r = lane & 31, hh = lane >> 5;
    const bool hi_half = hh != 0;
    const float* __restrict__ ABAR = (const float*)(P.ws + WS_ABAR); const bf16* __restrict__ BFRAG = (const bf16*)(P.ws + WS_BFRAG); const bf16* __restrict__ CFRAG = (const bf16*)(P.ws + WS_CFRAG);
    LAS unsigned char* img = lds + wid * 8192;
    const int i16 = lane & 15, tq = i16 >> 2, tp = i16 & 3, tblk = (lane >> 4) & 1;
    for (int item = vcu; item < 1024; item += G) {
        const int g8 = item & 15, c = (item >> 4) & 31, b = item >> 9; const int g = g8 * 8 + wid;
        const Cx A1a{ABAR[2 * (g * 64 + r)], ABAR[2 * (g * 64 + r) + 1]}, A1b{ABAR[2 * (g * 64 + 32 + r)], ABAR[2 * (g * 64 + 32 + r) + 1]};
        const Cx A2a = cmul(A1a, A1a), A3a = cmul(A2a, A1a), A4a = cmul(A2a, A2a);
        const Cx A2b = cmul(A1b, A1b), A3b = cmul(A2b, A1b), A4b = cmul(A2b, A2b);
        bf16x8 bfr[4];
#pragma unroll
        for (int k = 0; k < 4; ++k) bfr[k] = *(const bf16x8*)(BFRAG + ((size_t)(g * 4 + k) * 64 + lane) * 8);
        Cx Ha{0.f, 0.f}, Hb{0.f, 0.f};
        if (PASS == 1) {
            Cx Pa = cmul(A4a, A4a), Pb = cmul(A4b, A4b);
#pragma unroll
            for (int k = 0; k < 4; ++k) { Pa = cmul(Pa, Pa); Pb = cmul(Pb, Pb); }
            const Cx Pa2 = cmul(Pa, Pa), Pb2 = cmul(Pb, Pb), Pa4 = cmul(Pa2, Pa2), Pb4 = cmul(Pb2, Pb2);
            const float* sp = SBUF + ((size_t)(b * 128 + g) * 32) * 128;
            const int cq = c >> 2, kq = c & 3;
#pragma unroll 1
            for (int q = 0; q < cq; ++q) {
                const float* s3 = sp + (4 * q + 3) * 128;
                Ha = cfma(Pa4, Ha, Cx{s3[r], s3[64 + r]}); Hb = cfma(Pb4, Hb, Cx{s3[32 + r], s3[96 + r]});
            }
            if (kq > 0) {
                const Cx Pka = kq == 1 ? Pa : (kq == 2 ? Pa2 : cmul(Pa2, Pa)), Pkb = kq == 1 ? Pb : (kq == 2 ? Pb2 : cmul(Pb2, Pb));
                const float* sk = sp + (c - 1) * 128;
                Ha = cfma(Pka, Ha, Cx{sk[r], sk[64 + r]}); Hb = cfma(Pkb, Hb, Cx{sk[32 + r], sk[96 + r]});
            }
        }
        const bf16* up = U + ((size_t)b * TP + c * 128 + r) * DM + 16 * g + 8 * hh;
        bf16x8 unext = *(const bf16x8*)up;
        bf16x8 dfr;
        { const unsigned short dbits = (unsigned short)(cvtpk(r < 16 ? P.d_skip[16 * g + (r & 15)] : 0.f, 0.f) & 0xffffu);
#pragma unroll
          for (int j = 0; j < 8; ++j) dfr[j] = (8 * hh + j == r) ? (short)dbits : (short)0; }
#pragma unroll
        for (int sb = 0; sb < 4; ++sb) {
            const size_t row0 = (size_t)b * TP + c * 128 + sb * 32;
            const bf16x8 ua = unext; if (sb < 3) unext = *(const bf16x8*)(up + (size_t)(sb + 1) * 32 * DM);
            f32x16 z;
#pragma unroll
            for (int i = 0; i < 16; ++i) z[i] = 0.f;
            f32x16 re0 = MFMA32(ua, bfr[0], z), re1 = MFMA32(ua, bfr[1], z), im0 = MFMA32(ua, bfr[2], z), im1 = MFMA32(ua, bfr[3], z);
            scan_subblock<PASS == 1>(re0, im0, Ha, A1a, A2a, A3a, A4a, hi_half);
            scan_subblock<PASS == 1>(re1, im1, Hb, A1b, A2b, A3b, A4b, hi_half);
            if (PASS == 1) {
                store_img(img, re0, r, hh); store_img(img, re1, 32 + r, hh); store_img(img, im0, 64 + r, hh); store_img(img, im1, 96 + r, hh);
                asm volatile("s_waitcnt lgkmcnt(0)" ::: "memory");
                f32x16 y = MFMA32(ua, dfr, z);
#pragma unroll
                for (int s = 0; s < 8; ++s) {
                    const v4i16_t lo = tr_read(img + (16 * s + 8 * hh + tq) * 64 + 8 * (4 * tblk + tp)), hi = tr_read(img + (16 * s + 8 * hh + 4 + tq) * 64 + 8 * (4 * tblk + tp));
                    const bf16x8 xa = __builtin_shufflevector(lo, hi, 0, 1, 2, 3, 4, 5, 6, 7);
                    const bf16x8 cf = *(const bf16x8*)(CFRAG + ((size_t)(g * 8 + s) * 64 + lane) * 8);
                    y = MFMA32(xa, cf, y);
                }
                asm volatile("s_waitcnt lgkmcnt(0)" ::: "memory");
                LAS float* yt = (LAS float*)img;
                if (r < 16) {
#pragma unroll
                    for (int i = 0; i < 16; ++i) yt[crow(i, hh) * 16 + r] = y[i];
                }
                asm volatile("s_waitcnt lgkmcnt(0)" ::: "memory");
                { const int tk = lane >> 1, c8 = (lane & 1) * 8;
                  const f32x4 v0 = *(LAS const f32x4*)(yt + tk * 16 + c8), v1 = *(LAS const f32x4*)(yt + tk * 16 + c8 + 4);
                  float o[8] = {gelu_tanh_f(v0[0]), gelu_tanh_f(v0[1]), gelu_tanh_f(v0[2]), gelu_tanh_f(v0[3]), gelu_tanh_f(v1[0]), gelu_tanh_f(v1[1]), gelu_tanh_f(v1[2]), gelu_tanh_f(v1[3])};
                  *(u32x4*)(YG + (row0 + tk) * DM + 16 * g + c8) = pack8(o); }
                asm volatile("s_waitcnt lgkmcnt(0)" ::: "memory");
            }
        }
        if (PASS == 0) { if (!hi_half) { float* sp = (float*)SBUF + ((size_t)(b * 128 + g) * 32 + c) * 128; sp[r] = Ha.r; sp[64 + r] = Ha.i; sp[32 + r] = Hb.r; sp[96 + r] = Hb.i; } }
        else if (c == 31 && !hi_half) { float* o_re = P.out + OUT_SRP + (size_t)(b * 128 + g) * 64; float* o_im = P.out + OUT_SIP + (size_t)(b * 128 + g) * 64;
            o_re[r] = Ha.r; o_re[32 + r] = Hb.r; o_im[r] = Ha.i; o_im[32 + r] = Hb.i; }
    }
}
__device__ __forceinline__ void ssm_passA_phase(const Params& P, const bf16* __restrict__ U, float* __restrict__ SBUF, int vcu, int G) {
    int tid_ = threadIdx.x; asm volatile("" : "+v"(tid_)); const int tid = tid_, lane = tid & 63, wid = __builtin_amdgcn_readfirstlane(tid >> 6), r = lane & 31, hh = lane >> 5;
    const float* ABAR = (const float*)(P.ws + WS_ABAR); const bf16* BFRAG = (const bf16*)(P.ws + WS_BFRAG);
    for (int item = vcu; item < 256; item += G) {
        const int g8 = item & 15, cq = (item >> 4) & 7, b = item >> 7; const int g = g8 * 8 + wid;
        bf16x8 bfr[4];
#pragma unroll
        for (int k = 0; k < 4; ++k) bfr[k] = *(const bf16x8*)(BFRAG + ((size_t)(g * 4 + k) * 64 + lane) * 8);
        Cx Wt[2][16], A32[2];
#pragma unroll
        for (int st = 0; st < 2; ++st) {
            const int si = g * 64 + 32 * st + r; const Cx A1{ABAR[2 * si], ABAR[2 * si + 1]};
            const Cx A2 = cmul(A1, A1), A3 = cmul(A2, A1), A4 = cmul(A2, A2), A8 = cmul(A4, A4), A16 = cmul(A8, A8); A32[st] = cmul(A16, A16);
            const Cx base = hh ? Cx{1.f, 0.f} : A4;
            Wt[st][15] = base; Wt[st][14] = cmul(base, A1); Wt[st][13] = cmul(base, A2); Wt[st][12] = cmul(base, A3);
#pragma unroll
            for (int i = 11; i >= 0; --i) Wt[st][i] = cmul(Wt[st][i + 4], A8);
        }
        Cx Ha{0.f, 0.f}, Hb{0.f, 0.f};
        const bf16* up = U + ((size_t)b * TP + (size_t)cq * 512 + r) * DM + 16 * g + 8 * hh;
        bf16x8 unext = *(const bf16x8*)up;
#pragma unroll 1
        for (int j = 0; j < 16; ++j) {
            const bf16x8 ua = unext;
            unext = *(const bf16x8*)(up + (size_t)(j < 15 ? j + 1 : 15) * 32 * DM);
            f32x16 z;
#pragma unroll
            for (int i = 0; i < 16; ++i) z[i] = 0.f;
            const f32x16 re0 = MFMA32(ua, bfr[0], z), re1 = MFMA32(ua, bfr[1], z), im0 = MFMA32(ua, bfr[2], z), im1 = MFMA32(ua, bfr[3], z);
            Cx S0[4], S1[4];
#pragma unroll
            for (int q = 0; q < 4; ++q) { S0[q] = Cx{0.f, 0.f}; S1[q] = Cx{0.f, 0.f}; }
#pragma unroll
            for (int i = 0; i < 16; ++i) { S0[i & 3] = cfma(Wt[0][i], Cx{re0[i], im0[i]}, S0[i & 3]); S1[i & 3] = cfma(Wt[1][i], Cx{re1[i], im1[i]}, S1[i & 3]); }
            Cx Sa{(S0[0].r + S0[1].r) + (S0[2].r + S0[3].r), (S0[0].i + S0[1].i) + (S0[2].i + S0[3].i)}, Sb{(S1[0].r + S1[1].r) + (S1[2].r + S1[3].r), (S1[0].i + S1[1].i) + (S1[2].i + S1[3].i)};
            const Cx Sao = cshfl32(Sa), Sbo = cshfl32(Sb);
            Sa.r += Sao.r; Sa.i += Sao.i; Sb.r += Sbo.r; Sb.i += Sbo.i;
            Ha = cfma(A32[0], Ha, Sa); Hb = cfma(A32[1], Hb, Sb);
            if ((j & 3) == 3 && !hh) { float* sp = SBUF + ((size_t)(b * 128 + g) * 32 + 4 * cq + (j >> 2)) * 128; sp[r] = Ha.r; sp[64 + r] = Ha.i; sp[32 + r] = Hb.r; sp[96 + r] = Hb.i; }
        }
    }
}
__device__ __forceinline__ void ssm_sample_item(const Params& P, const bf16* __restrict__ U, bf16* __restrict__ YG, int item, int lane) {
    const int b = item >> 7, g = item & 127, sidx = g * 64 + lane;
    const float* __restrict__ ABAR = (const float*)(P.ws + WS_ABAR); const float* __restrict__ BBRE = (const float*)(P.ws + WS_BBRE); const float* __restrict__ BBIM = (const float*)(P.ws + WS_BBIM);
    const Cx A{ABAR[2 * sidx], ABAR[2 * sidx + 1]};
    float br[16], bi[16], cr[16], ci[16];
#pragma unroll
    for (int k4 = 0; k4 < 4; ++k4) { const f32x4 a = *(const f32x4*)(BBRE + (size_t)sidx * 16 + 4 * k4), c = *(const f32x4*)(BBIM + (size_t)sidx * 16 + 4 * k4);
        br[4 * k4] = a[0]; br[4 * k4 + 1] = a[1]; br[4 * k4 + 2] = a[2]; br[4 * k4 + 3] = a[3]; bi[4 * k4] = c[0]; bi[4 * k4 + 1] = c[1]; bi[4 * k4 + 2] = c[2]; bi[4 * k4 + 3] = c[3]; }
#pragma unroll
    for (int k = 0; k < 16; ++k) { cr[k] = P.c_re[((size_t)g * 16 + k) * 64 + lane]; ci[k] = P.c_im[((size_t)g * 16 + k) * 64 + lane]; }
    Cx H{P.ssm_re[(size_t)(b * 128 + g) * 64 + lane], P.ssm_im[(size_t)(b * 128 + g) * 64 + lane]};
    const int kk = ((lane & 1) << 3) | ((lane & 2) << 1) | ((lane & 4) >> 1) | ((lane & 8) >> 3);
    const float dsk = P.d_skip[16 * g + kk];
    u32x4 ur[8][2];
#pragma unroll
    for (int t = 0; t < 8; ++t) { const size_t off = (size_t)(MP + b * 8 + t) * DM + 16 * g; ur[t][0] = *(const u32x4*)(U + off); ur[t][1] = *(const u32x4*)(U + off + 8); }
#pragma unroll
    for (int t = 0; t < 8; ++t) {
        const size_t off = (size_t)(MP + b * 8 + t) * DM + 16 * g;
        float uu[16]; { float t0[8], t1[8]; unpack8(ur[t][0], t0); unpack8(ur[t][1], t1);
#pragma unroll
            for (int e = 0; e < 8; ++e) { uu[e] = t0[e]; uu[8 + e] = t1[e]; } }
        Cx bu{0.f, 0.f};
#pragma unroll
        for (int k = 0; k < 16; ++k) { bu.r += br[k] * uu[k]; bu.i += bi[k] * uu[k]; }
        H = cfma(A, H, bu);
        float v[16];
#pragma unroll
        for (int k = 0; k < 16; ++k) v[k] = cr[k] * H.r - ci[k] * H.i;
        const float tot = reduce16(v, lane);
        float uk = 0.f;
#pragma unroll
        for (int k = 0; k < 16; ++k) if (kk == k) uk = uu[k];
        if (lane < 16) YG[off + kk] = (bf16)(cvtpk(gelu_tanh_f(tot + dsk * uk), 0.f) & 0xffffu);
    }
    P.out[OUT_SRS + (size_t)(b * 128 + g) * 64 + lane] = H.r; P.out[OUT_SIS + (size_t)(b * 128 + g) * 64 + lane] = H.i;
}

#define XB_TMO      128
#define XB_XCNT(j)  (256  + 64 * (j))
#define XB_XSUB(j)  (1280 + 64 * (j))
#define XB_XGEN(j)  (2304 + 64 * (j))
#define XB_TOP      3328
#define XB_TOPGEN   3392
#define XCD_BAR_WORDS 3456
#define XB_SPIN_CAP (1u << 18)

__device__ __forceinline__ unsigned xb_ld(unsigned* p)              { return __hip_atomic_load(p, __ATOMIC_RELAXED, __HIP_MEMORY_SCOPE_AGENT); }
__device__ __forceinline__ unsigned xb_add(unsigned* p, unsigned v) { return __hip_atomic_fetch_add(p, v, __ATOMIC_RELAXED, __HIP_MEMORY_SCOPE_AGENT); }
__device__ __forceinline__ unsigned xb_xcc_id() { return (unsigned)__builtin_amdgcn_s_getreg((3 << 11) | 20) & 0xFu; }
#define XB_SPIN(cond, bar) do { unsigned _sp = 0; while (cond) { __builtin_amdgcn_s_sleep(1); \
    if ((++_sp & 255u) == 0u) { if (xb_ld(&(bar)[XB_TMO])) break; if (_sp > XB_SPIN_CAP) { atomicAdd(&(bar)[XB_TMO], 1u); break; } } } } while (0)

struct XcdBarrier {
    unsigned* bar; unsigned x;
    volatile LAS unsigned* st;
};

__device__ __forceinline__ XcdBarrier xcd_barrier_post(unsigned* bar, volatile LAS unsigned* st) {
    XcdBarrier b; b.bar = bar; b.x = xb_xcc_id(); b.st = st;
    if (threadIdx.x == 0) (void)xb_add(&bar[XB_XCNT(b.x)], 1u);
    return b;
}
__device__ __forceinline__ void xcd_barrier_complete(unsigned* bar, unsigned x, unsigned& nloc, unsigned& nx) {
    const unsigned G = gridDim.x * gridDim.y * gridDim.z;
    unsigned sum, cnt, mine, sp = 0u;
    for (;;) {
        sum = 0u; cnt = 0u; mine = 0u;
#pragma unroll
        for (unsigned j = 0; j < 16; ++j) { const unsigned c = xb_ld(&bar[XB_XCNT(j)]); sum += c; cnt += (c > 0u) ? 1u : 0u; mine = (j == x) ? c : mine; }
        if (sum == G) break;
        __builtin_amdgcn_s_sleep(1);
        if ((++sp & 255u) == 0u) { if (xb_ld(&bar[XB_TMO])) break; if (sp > XB_SPIN_CAP) { atomicAdd(&bar[XB_TMO], 1u); break; } }
    }
    nloc = mine > 0u ? mine : 1u; nx = cnt > 0u ? cnt : 1u;
}

__device__ __forceinline__ void xcd_barrier(const XcdBarrier& b) {
    asm volatile("s_waitcnt vmcnt(0)" ::: "memory");
    __syncthreads();
    if (threadIdx.x == 0) {
        unsigned* bar = b.bar;
        __builtin_amdgcn_s_waitcnt(0);
        unsigned nloc = b.st[0], nx = b.st[1];
        if (nloc == 0u) { xcd_barrier_complete(bar, b.x, nloc, nx); b.st[0] = nloc; b.st[1] = nx; }
        const unsigned old = xb_add(&bar[XB_XSUB(b.x)], 1u);
        const unsigned gen = old / nloc;
        if (old + 1u == (gen + 1u) * nloc) {
            __builtin_amdgcn_fence(__ATOMIC_RELEASE, "agent");
            asm volatile("s_waitcnt vmcnt(0)" ::: "memory");
            const unsigned og = xb_add(&bar[XB_TOP], 1u);
            const unsigned tg = og / nx;
            if (og + 1u == (tg + 1u) * nx) xb_add(&bar[XB_TOPGEN], 1u);
            else XB_SPIN(xb_ld(&bar[XB_TOPGEN]) == tg, bar);
            __builtin_amdgcn_fence(__ATOMIC_ACQUIRE, "agent");
            xb_add(&bar[XB_XGEN(b.x)], 1u);
            asm volatile("s_waitcnt vmcnt(0)" ::: "memory");
        } else {
            XB_SPIN(xb_ld(&bar[XB_XGEN(b.x)]) == gen, bar);
            __builtin_amdgcn_fence(__ATOMIC_ACQUIRE, "agent");
            asm volatile("s_waitcnt vmcnt(0)" ::: "memory");
        }
    }
    __syncthreads();
}

#define AS4 __attribute__((address_space(4)))
__device__ __forceinline__ Params load_params() {
    typedef const float* cfp;
    const AS4 cfp* ka = (const AS4 cfp*)__builtin_amdgcn_kernarg_segment_ptr();
    asm volatile("" : "+s"(ka));
    Params q;
    q.x_prompt = ka[0]; q.x_sample = ka[1]; q.cache_k = ka[2]; q.cache_v = ka[3]; q.state_conv = ka[4]; q.ssm_re = ka[5]; q.ssm_im = ka[6]; q.attn_norm = ka[7]; q.w_in_ab = ka[8];
    q.conv_w = ka[9]; q.w_out_ab = ka[10]; q.ssm_norm = ka[11]; q.w_in_c = ka[12]; q.lam_re = ka[13]; q.lam_im = ka[14]; q.log_step = ka[15]; q.b_re = ka[16]; q.b_im = ka[17];
    q.c_re = ka[18]; q.c_im = ka[19]; q.d_skip = ka[20]; q.w_glu = ka[21]; q.b_glu = ka[22]; q.w_out_c = ka[23]; q.final_norm = ka[24]; q.out = (float*)ka[25]; q.ws = (unsigned char*)ka[26];
    return q;
}
#define PHASE_VARS const Params P = load_params(); unsigned char* ws = P.ws; bf16* X0 = (bf16*)(ws + WS_A); bf16* ACT1 = X0; bf16* U = X0; bf16* Qb = (bf16*)(ws + WS_B); bf16* Kb = (bf16*)(ws + WS_B + HALF_SLOT); bf16* H1b = Qb; bf16* YG = (bf16*)(ws + WS_OG); bf16* Vb = (bf16*)(ws + WS_C); bf16* SZA = (bf16*)(ws + WS_C + HALF_SLOT); bf16* ZS = Vb; bf16* CH = (bf16*)(ws + WS_D); bf16* GB = (bf16*)(ws + WS_D + HALF_SLOT); bf16* ACT2 = CH; bf16* OG = (bf16*)(ws + WS_OG); float* L2G = (float*)(ws + WS_L2G); float* SBUF = (float*)(ws + WS_SBUF); float* rs0 = (float*)(ws + WS_RS0); float* rss1 = (float*)(ws + WS_RSS1); float* rss2 = (float*)(ws + WS_RSS2); const bf16* W1 = (const bf16*)(ws + WS_W1); const bf16* W2 = (const bf16*)(ws + WS_W2); const bf16* W3 = (const bf16*)(ws + WS_W3); const bf16* W4 = (const bf16*)(ws + WS_W4); const bf16* W5 = (const bf16*)(ws + WS_W5);
__global__ void __launch_bounds__(NTHREADS) fwd_megakernel(Params Pk) {
    extern __shared__ __attribute__((aligned(16))) unsigned char lds_raw[];
    LAS unsigned char* lds = (LAS unsigned char*)lds_raw;
    int tid_ = threadIdx.x; asm volatile("" : "+v"(tid_)); const int tid = tid_, lane = tid & 63, wave = __builtin_amdgcn_readfirstlane(tid >> 6);
    const int G = gridDim.x, bx = blockIdx.x; const int vcu = (G % 8 == 0) ? (bx % 8) * (G / 8) + bx / 8 : bx;
    const int gw = vcu * NWAVES + wave, NGW = G * NWAVES;
    unsigned* barw = (unsigned*)(Pk.ws + WS_BAR);
    volatile LAS unsigned* bar_st = (volatile LAS unsigned*)(lds + 131072);
    if (tid < 2) bar_st[tid] = 0u;
    __syncthreads();
    XcdBarrier xbar = xcd_barrier_post(barw, bar_st);
#ifndef ONLY_PHASE
#define PH(k) true
#else
#define PH(k) ((k)==ONLY_PHASE)
#endif
#define GSYNC() do { xcd_barrier(xbar); if (REP_PHASE == 100) { xcd_barrier(xbar); xcd_barrier(xbar); } } while (0)
#define RUNP(k, ...) do { { PHASE_VARS __VA_ARGS__ } GSYNC(); if ((k) == REP_PHASE) { { PHASE_VARS __VA_ARGS__ } GSYNC(); } } while (0)
    { PHASE_VARS if (PH(0)) p0_prologue(P, lds, gw, NGW, lane, wave); }
    GSYNC();
    if (REP_PHASE == 0) { { PHASE_VARS if (PH(0)) p0_prologue(P, lds, gw, NGW, lane, wave); } GSYNC(); }
    RUNP(1, if (PH(1)) { E1 e{Qb, Kb, Vb, SZA, CH, GB, rs0, (const float*)(ws + WS_ROPE), P.out}; gemm_all<E1, false>(lds, X0, W1, 8192, e, nullptr, vcu, G); });
    RUNP(2, if (G == 256) {
                const int xq = vcu >> 5, xr = vcu & 31;
                if (xr >= 20) { const int wq = (xr - 20) * 8 + wave;
                    _Pragma("unroll 1") for (int it = 0; it < (REP_PHASE == 22 ? 4 : 2); ++it) { const int combo = (wq >> 3) + 12 * (it & 1), hq = combo & 7, gq = combo >> 3, sq = wq & 7;
                        attn_sample_item((LAS float*)(lds + 104448 + wave * 1024), ((xq * 8 + sq) * 8 + hq) * 3 + gq, P, Qb, Kb, Vb, OG, L2G, lane); } }
                else { attn_prompt_phase(lds, Qb, Kb, Vb, OG, L2G, vcu, -20); if (REP_PHASE == 23) attn_prompt_phase(lds, Qb, Kb, Vb, OG, L2G, vcu, -20); }
            } else {
                if (gw < 1536) attn_sample_item((LAS float*)(lds + 104448 + wave * 1024), gw, P, Qb, Kb, Vb, OG, L2G, lane);
                attn_prompt_phase(lds, Qb, Kb, Vb, OG, L2G, vcu, G);
            });
    RUNP(4, if (PH(4)) merge_conv_phase(P, OG, L2G, SZA, CH, GB, ACT1, gw * 64 + lane, NGW * 64););
    RUNP(-5, if (PH(5)) { E2 e{P.x_prompt, P.x_sample, H1b}; gemm_all<E2, true>(lds, ACT1, W2, 2048, e, rss1, vcu, G); });
    RUNP(6, if (PH(6)) { E3 e{rss1, U, ZS}; gemm_all<E3, false>(lds, H1b, W3, 4096, e, nullptr, vcu, G); });
    RUNP(7, if (PH(7)) ssm_passA_phase(P, U, SBUF, vcu, G);
            if (PH(8)) for (int it = gw; it < 1024; it += NGW) ssm_sample_item(P, U, YG, it, lane););
    RUNP(9, if (PH(9)) ssm_prompt_phase<1>(lds, P, U, YG, SBUF, vcu, G););
    RUNP(10, if (PH(10)) { E4 e{YG, ZS, P.b_glu, ACT2}; gemm_all<E4, false>(lds, YG, W4, 2048, e, nullptr, vcu, G); });
    if (G == 256) { PHASE_VARS if (PH(11)) gemm5_fused(lds, ACT2, W5, H1b, P.out, rss2, (unsigned*)(ws + WS_CNT), P.final_norm, vcu, G); return; }
    RUNP(-11, if (PH(11)) { E5 e{H1b, P.out}; gemm_all<E5, true>(lds, ACT2, W5, 2048, e, rss2, vcu, G); });
    if (PH(12)) {
        PHASE_VARS
        const int gt = gw * 64 + lane, ngt = NGW * 64; constexpr int NI = MR * 512, UB = 4;
        float* __restrict__ outp = P.out; const float* __restrict__ fn = P.final_norm; const float* __restrict__ r2p = rss2;
        for (int base = gt; base < NI; base += UB * ngt) {
            f32x4 v[UB]; float rq[UB];
#pragma unroll
            for (int u = 0; u < UB; ++u) { const int idx = base + u * ngt; if (idx < NI) { v[u] = *(const f32x4*)(outp + (size_t)idx * 4); rq[u] = r2p[idx >> 9]; } }
#pragma unroll
            for (int u = 0; u < UB; ++u) { const int idx = base + u * ngt; if (idx < NI) { const int c4 = (idx & 511) * 4;
                const float rs = 1.0f / sqrtf(rq[u] * (1.0f / DM) + RMS_EPS); const f32x4 gg = *(const f32x4*)(fn + c4); f32x4 w = v[u];
                w[0] *= rs * gg[0]; w[1] *= rs * gg[1]; w[2] *= rs * gg[2]; w[3] *= rs * gg[3];
                *(f32x4*)(outp + (size_t)idx * 4) = w; } }
        }
    }
}

extern "C" void kernel_launch(void* const* d_in, const int* in_sizes, int n_in, void* d_out, int out_size, void* d_ws, size_t ws_size, hipStream_t stream) {
    static int grid_blocks = 0;
    if (grid_blocks == 0) {
        if (n_in != 25 || ws_size < WS_END) { fprintf(stderr, "kernel_launch: unexpected n_in %d / ws_size %zu\n", n_in, ws_size); grid_blocks = -1; return; }
        int dev = 0, cus = 0, per_cu = 0;
        hipGetDevice(&dev); hipDeviceGetAttribute(&cus, hipDeviceAttributeMultiprocessorCount, dev);
        hipFuncSetAttribute((const void*)fwd_megakernel, hipFuncAttributeMaxDynamicSharedMemorySize, LDS_BYTES);
        hipOccupancyMaxActiveBlocksPerMultiprocessor(&per_cu, (const void*)fwd_megakernel, NTHREADS, LDS_BYTES);
        if (per_cu < 1) { fprintf(stderr, "kernel_launch: occupancy query says %d blocks per CU\n", per_cu); per_cu = 1; }
        (void)hipGetLastError();
        grid_blocks = cus;
    }
    if (grid_blocks < 0) return;
    if (hipMemsetAsync((char*)d_ws + WS_BAR, 0, (WS_CNT - WS_BAR) + 64 * 48 * 4, stream) != hipSuccess) { fprintf(stderr, "kernel_launch: memset of the barrier words failed\n"); return; }
    Params p{};
    const float** pp = (const float**)&p;
    for (int i = 0; i < 25; ++i) pp[i] = (const float*)d_in[i];
    p.out = (float*)d_out; p.ws = (unsigned char*)d_ws;
    void* args[] = {&p};
    hipError_t e = hipLaunchCooperativeKernel((const void*)fwd_megakernel, dim3(grid_blocks), dim3(NTHREADS), args, LDS_BYTES, stream);
    if (e != hipSuccess) fprintf(stderr, "cooperative launch failed: %s (grid %d)\n", hipGetErrorString(e), grid_blocks);
}
```
